# Optimizing an MI355X kernel written in HIP

```python
import math
import jax
import jax.numpy as jnp
from jax import lax
import numpy as np

D_MODEL = 1024
BATCH = 8
SEQ = 4096
DEPTH = 2

GRID_W = 64
CTX_LEN = 256
HEAD_DIM = 64
GROUP_WIDTH = D_MODEL // 4
D_MIX = 4 * GROUP_WIDTH
EPS = 1e-6
NEG_INF = -1e30
ROPE_BASE = 10000.0

A_HEADS = GROUP_WIDTH // HEAD_DIM
A_KV_HEADS = A_HEADS // 2
A_WINDOW = 128
A_BLOCK = 128

B_HEADS = GROUP_WIDTH // HEAD_DIM
B_NOPE = HEAD_DIM
B_ROPE = HEAD_DIM // 2
B_VDIM = HEAD_DIM
B_Q_LORA = 3 * GROUP_WIDTH // 4
B_KV_LORA = GROUP_WIDTH // 2
MLA_BLOCK = 128

C_CH = GROUP_WIDTH
C_GROUP = 16
C_NGROUPS = C_CH // C_GROUP
C_STATE = 64
STEP_MIN = 0.001
STEP_MAX = 0.1

D_HEADS = GROUP_WIDTH // HEAD_DIM
NA_KH = 8
NA_KW = 16

PEER_HEADS = 8
PEER_NKEYS = 128
PEER_NEXPERTS = PEER_NKEYS * PEER_NKEYS
PEER_DKEY = 256
PEER_TOPK = 16
PEER_CHUNK = 128

IN_SIZES = (A_HEADS * HEAD_DIM, A_KV_HEADS * HEAD_DIM, A_KV_HEADS * HEAD_DIM,
            B_Q_LORA, B_KV_LORA, B_ROPE,
            C_CH,
            D_HEADS * HEAD_DIM, D_HEADS * HEAD_DIM, D_HEADS * HEAD_DIM)
IN_WIDTH = sum(IN_SIZES)

kernel_name = 'hybrid_dit_block'


def rmsnorm(x, g):
    xf = x.astype(jnp.float32)
    y = xf * lax.rsqrt(jnp.mean(xf * xf, axis=-1, keepdims=True) + EPS)
    return (y * g.astype(jnp.float32)).astype(x.dtype)


def group_rmsnorm(y, g):
    shp = y.shape
    yf = y.astype(jnp.float32).reshape(shp[:-1] + (4, GROUP_WIDTH))
    yf = yf * lax.rsqrt(jnp.mean(yf * yf, axis=-1, keepdims=True) + EPS)
    return (yf.reshape(shp) * g.astype(jnp.float32)).astype(y.dtype)


def modulate(x, g, shift, scale):
    return rmsnorm(x, g) * (1 + scale) + shift


def split_cols(z):
    offs = np.cumsum(IN_SIZES)[:-1].tolist()
    return jnp.split(z, offs, axis=-1)


def joint_softmax(parts):
    sizes = [p.shape[-1] for p in parts]
    probs = jax.nn.softmax(jnp.concatenate(parts, axis=-1), axis=-1)
    return jnp.split(probs, np.cumsum(sizes)[:-1].tolist(), axis=-1)


def _rope_axis(x, pos):
    half = x.shape[-1] // 2
    inv_freq = ROPE_BASE ** (-jnp.arange(half, dtype=jnp.float32) / half)
    ang = pos.astype(jnp.float32)[:, None] * inv_freq[None, :]
    cos = jnp.cos(ang)[:, None, :]
    sin = jnp.sin(ang)[:, None, :]
    xf = x.astype(jnp.float32)
    x1, x2 = xf[..., :half], xf[..., half:]
    return jnp.concatenate([x1 * cos - x2 * sin, x1 * sin + x2 * cos], axis=-1)


def axial_rope(x, row_pos, col_pos):
    a = x.shape[-1] // 2
    return jnp.concatenate([_rope_axis(x[..., :a], row_pos), _rope_axis(x[..., a:], col_pos)], axis=-1).astype(x.dtype)


def dense_attention(q, k, v):
    s = jnp.einsum('bqhd,bkhd->bhqk', q, k).astype(jnp.float32) * (q.shape[-1] ** -0.5)
    p = jax.nn.softmax(s, axis=-1).astype(v.dtype)
    o = jnp.einsum('bhqk,bkhd->bqhd', p, v)
    return o.reshape(o.shape[0], o.shape[1], -1)


def swa_mixer(q, k, v, qc, kc, vc, sink):
    B_, L = q.shape[:2]
    nb = L // A_BLOCK
    rep = A_HEADS // A_KV_HEADS
    scale = HEAD_DIM ** -0.5
    sink_l = sink.astype(jnp.float32).reshape(A_KV_HEADS, rep, 1, 1)

    def band_blocks(t):
        tp = jnp.pad(t, ((0, 0), (A_BLOCK, A_BLOCK), (0, 0), (0, 0)))
        tp = tp.reshape(B_, nb + 2, A_BLOCK, A_KV_HEADS, HEAD_DIM)
        return jnp.concatenate([tp[:, :-2], tp[:, 1:-1], tp[:, 2:]], axis=2)

    kw, vw = band_blocks(k), band_blocks(v)
    qb = q.reshape(B_, nb, A_BLOCK, A_KV_HEADS, rep, HEAD_DIM)
    s_loc = jnp.einsum('bnqgrd,bnkgd->bngrqk', qb, kw).astype(jnp.float32) * scale
    s_ctx = jnp.einsum('bnqgrd,bkgd->bngrqk', qb, kc).astype(jnp.float32) * scale
    qi = jnp.arange(A_BLOCK)[:, None]
    kj = jnp.arange(3 * A_BLOCK)[None, :]
    key_pos = (jnp.arange(nb)[:, None, None] - 1) * A_BLOCK + kj[None]
    valid = (jnp.abs(qi + A_BLOCK - kj) <= A_WINDOW)[None] & (key_pos >= 0) & (key_pos < L)
    s_loc = jnp.where(valid[None, :, None, None], s_loc, NEG_INF)
    sink_b = jnp.broadcast_to(sink_l, s_loc.shape[:-1] + (1,))
    p_loc, p_ctx, _ = joint_softmax([s_loc, s_ctx, sink_b])
    o = (jnp.einsum('bngrqk,bnkgd->bnqgrd', p_loc.astype(v.dtype), vw)
         + jnp.einsum('bngrqk,bkgd->bnqgrd', p_ctx.astype(vc.dtype), vc))
    y = o.reshape(B_, L, A_HEADS * HEAD_DIM)
    yc = None
    if qc is not None:
        Lc = qc.shape[1]
        qcb = qc.reshape(B_, Lc, A_KV_HEADS, rep, HEAD_DIM)
        s = jnp.einsum('bqgrd,bkgd->bgrqk', qcb, kc).astype(jnp.float32) * scale
        p_c, _ = joint_softmax([s, jnp.broadcast_to(sink_l, s.shape[:-1] + (1,))])
        yc = jnp.einsum('bgrqk,bkgd->bqgrd', p_c.astype(vc.dtype), vc).reshape(B_, Lc, A_HEADS * HEAD_DIM)
    return y, yc


def mla_q(cq, qn_g, w_uq, row_pos, col_pos):
    B_, L = cq.shape[:2]
    q = (rmsnorm(cq, qn_g) @ w_uq).reshape(B_, L, B_HEADS, B_NOPE + B_ROPE)
    q_nope, q_rope = q[..., :B_NOPE], q[..., B_NOPE:]
    if row_pos is not None:
        q_rope = axial_rope(q_rope, row_pos, col_pos)
    return jnp.concatenate([q_nope, q_rope], axis=-1)


def mla_kv(ckv, kr, kvn_g, w_ukv, row_pos, col_pos):
    B_, L = ckv.shape[:2]
    kv = (rmsnorm(ckv, kvn_g) @ w_ukv).reshape(B_, L, B_HEADS, B_NOPE + B_VDIM)
    k_nope, v = kv[..., :B_NOPE], kv[..., B_NOPE:]
    k_rope = kr[:, :, None, :]
    if row_pos is not None:
        k_rope = axial_rope(k_rope, row_pos, col_pos)
    k = jnp.concatenate([k_nope, jnp.broadcast_to(k_rope, (B_, L, B_HEADS, B_ROPE))], axis=-1)
    return k, v


def mla_mixer(q, k, v, qc, kc, vc):
    B_, L = q.shape[:2]
    nb = L // MLA_BLOCK
    scale = (B_NOPE + B_ROPE) ** -0.5
    qb = jnp.moveaxis(q.reshape(B_, nb, MLA_BLOCK, B_HEADS, B_NOPE + B_ROPE), 1, 0)

    def block(q_i):
        s_lat = jnp.einsum('bqhd,bkhd->bhqk', q_i, k).astype(jnp.float32) * scale
        s_ctx = jnp.einsum('bqhd,bkhd->bhqk', q_i, kc).astype(jnp.float32) * scale
        p_lat, p_ctx = joint_softmax([s_lat, s_ctx])
        return (jnp.einsum('bhqk,bkhd->bqhd', p_lat.astype(v.dtype), v)
                + jnp.einsum('bhqk,bkhd->bqhd', p_ctx.astype(vc.dtype), vc))

    o = lax.map(block, qb)
    y = jnp.moveaxis(o, 0, 1).reshape(B_, L, B_HEADS * B_VDIM)
    yc = dense_attention(qc, kc, vc) if qc is not None else None
    return y, yc


def s5_discretize(lam_re, lam_im, log_step, b_re, b_im):
    lr, li = lam_re.astype(jnp.float32), lam_im.astype(jnp.float32)
    step = jnp.exp(log_step.astype(jnp.float32))[:, None]
    mag = jnp.exp(lr * step)
    abr, abi = mag * jnp.cos(li * step), mag * jnp.sin(li * step)
    nr, ni = abr - 1.0, abi
    den = lr * lr + li * li
    fr = (nr * lr + ni * li) / den
    fi = (ni * lr - nr * li) / den
    br, bi = b_re.astype(jnp.float32), b_im.astype(jnp.float32)
    bbr = fr[..., None] * br - fi[..., None] * bi
    bbi = fr[..., None] * bi + fi[..., None] * br
    return abr, abi, bbr, bbi


def _cmul_combine(e1, e2):
    a1r, a1i, b1r, b1i = e1
    a2r, a2i, b2r, b2i = e2
    return (a2r * a1r - a2i * a1i, a2r * a1i + a2i * a1r,
            a2r * b1r - a2i * b1i + b2r, a2r * b1i + a2i * b1r + b2i)


def s5_scan(u, abr, abi, bbr, bbi, h0r, h0i, reverse):
    bu_r = jnp.einsum('blgc,gpc->blgp', u, bbr)
    bu_i = jnp.einsum('blgc,gpc->blgp', u, bbi)
    first = -1 if reverse else 0
    bu_r = bu_r.at[:, first].add(abr * h0r - abi * h0i)
    bu_i = bu_i.at[:, first].add(abr * h0i + abi * h0r)
    a_r = jnp.broadcast_to(abr, bu_r.shape)
    a_i = jnp.broadcast_to(abi, bu_i.shape)
    _, _, h_r, h_i = lax.associative_scan(_cmul_combine, (a_r, a_i, bu_r, bu_i), reverse=reverse, axis=1)
    return h_r, h_i


def s5_readout(h_r, h_i, c_r, c_i):
    return jnp.einsum('blgp,gcp->blgc', h_r, c_r) - jnp.einsum('blgp,gcp->blgc', h_i, c_i)


def s5_glu(y, w_glu, dtype):
    z = jax.nn.gelu(y).astype(w_glu.dtype) @ w_glu
    a, g = jnp.split(z, 2, axis=-1)
    return (a * jax.nn.sigmoid(g)).astype(dtype)


def s5_mixer(u, uc, lam_re, lam_im, log_step, b_re, b_im, c_re, c_im, d_skip, w_glu, need_ctx_out):
    B_, L = u.shape[:2]
    Lc = uc.shape[1]
    d_g = d_skip.astype(jnp.float32).reshape(C_NGROUPS, C_GROUP)
    ug = u.astype(jnp.float32).reshape(B_, L, C_NGROUPS, C_GROUP)
    ucg = uc.astype(jnp.float32).reshape(B_, Lc, C_NGROUPS, C_GROUP)
    y = ug * d_g
    yc = ucg * d_g if need_ctx_out else None
    h0 = jnp.zeros((B_, C_NGROUPS, C_STATE), jnp.float32)
    for dirn, reverse in ((0, False), (1, True)):
        abr, abi, bbr, bbi = s5_discretize(lam_re[dirn], lam_im[dirn], log_step[dirn], b_re[dirn], b_im[dirn])
        c_r, c_i = c_re[dirn].astype(jnp.float32), c_im[dirn].astype(jnp.float32)
        hc_r, hc_i = s5_scan(ucg, abr, abi, bbr, bbi, h0, h0, reverse)
        last = 0 if reverse else -1
        h_r, h_i = s5_scan(ug, abr, abi, bbr, bbi, hc_r[:, last], hc_i[:, last], reverse)
        y = y + s5_readout(h_r, h_i, c_r, c_i)
        if need_ctx_out:
            yc = yc + s5_readout(hc_r, hc_i, c_r, c_i)
    y_out = s5_glu(y.reshape(B_, L, C_CH), w_glu, u.dtype)
    yc_out = s5_glu(yc.reshape(B_, Lc, C_CH), w_glu, uc.dtype) if need_ctx_out else None
    return y_out, yc_out


def natten_mixer(q, k, v, qc, kc, vc, rpb):
    B_, L = q.shape[:2]
    n_rows = L // GRID_W
    kh = min(NA_KH, n_rows)
    scale = HEAD_DIM ** -0.5
    qg = q.reshape(B_, n_rows, GRID_W, D_HEADS, HEAD_DIM)
    kg = k.reshape(B_, n_rows, GRID_W, D_HEADS, HEAD_DIM)
    vg = v.reshape(B_, n_rows, GRID_W, D_HEADS, HEAD_DIM)
    col = jnp.arange(GRID_W)
    col_idx = jnp.clip(col - NA_KW // 2, 0, GRID_W - NA_KW)[:, None] + jnp.arange(NA_KW)[None, :]
    rpb_cols = rpb.astype(jnp.float32)[:, :, col_idx - col[:, None] + (NA_KW - 1)]

    def row_block(r):
        r0 = jnp.clip(r - kh // 2, 0, n_rows - kh)
        k_sel = lax.dynamic_slice_in_dim(kg, r0, kh, axis=1)[:, :, col_idx]
        v_sel = lax.dynamic_slice_in_dim(vg, r0, kh, axis=1)[:, :, col_idx]
        q_r = lax.dynamic_index_in_dim(qg, r, axis=1, keepdims=False)
        s_loc = jnp.einsum('bwhd,bywjhd->bhwyj', q_r, k_sel).astype(jnp.float32) * scale
        bias = jnp.transpose(rpb_cols[:, r0 + jnp.arange(kh) - r + (NA_KH - 1)], (0, 2, 1, 3))
        s_loc = (s_loc + bias[None]).reshape(B_, D_HEADS, GRID_W, kh * NA_KW)
        s_ctx = jnp.einsum('bwhd,bkhd->bhwk', q_r, kc).astype(jnp.float32) * scale
        p_loc, p_ctx = joint_softmax([s_loc, s_ctx])
        p_loc = p_loc.reshape(B_, D_HEADS, GRID_W, kh, NA_KW).astype(v.dtype)
        return (jnp.einsum('bhwyj,bywjhd->bwhd', p_loc, v_sel)
                + jnp.einsum('bhwk,bkhd->bwhd', p_ctx.astype(vc.dtype), vc))

    o = lax.map(row_block, jnp.arange(n_rows))
    y = jnp.moveaxis(o, 0, 1).reshape(B_, L, D_HEADS * HEAD_DIM)
    yc = dense_attention(qc, kc, vc) if qc is not None else None
    return y, yc


def token_mixers(h, hc, row_pos, col_pos, p, need_ctx_out):
    aq, ak, av, bq, bkv, bkr, cu, dq, dk, dv = split_cols(h @ p['w_in'])
    aqc, akc, avc, bqc, bkvc, bkrc, cuc, dqc, dkc, dvc = split_cols(hc @ p['w_in'])

    def heads(t, n):
        return t.reshape(t.shape[0], t.shape[1], n, HEAD_DIM)

    y_a, y_ac = swa_mixer(axial_rope(heads(aq, A_HEADS), row_pos, col_pos),
                          axial_rope(heads(ak, A_KV_HEADS), row_pos, col_pos),
                          heads(av, A_KV_HEADS),
                          heads(aqc, A_HEADS) if need_ctx_out else None,
                          heads(akc, A_KV_HEADS), heads(avc, A_KV_HEADS), p['swa_sink'])

    q_b = mla_q(bq, p['mla_q_norm_g'], p['mla_w_uq'], row_pos, col_pos)
    k_b, v_b = mla_kv(bkv, bkr, p['mla_kv_norm_g'], p['mla_w_ukv'], row_pos, col_pos)
    k_bc, v_bc = mla_kv(bkvc, bkrc, p['mla_kv_norm_g'], p['mla_w_ukv'], None, None)
    q_bc = mla_q(bqc, p['mla_q_norm_g'], p['mla_w_uq'], None, None) if need_ctx_out else None
    y_b, y_bc = mla_mixer(q_b, k_b, v_b, q_bc, k_bc, v_bc)

    y_s, y_sc = s5_mixer(cu, cuc, p['s5_lambda_re'], p['s5_lambda_im'], p['s5_log_step'],
                         p['s5_b_re'], p['s5_b_im'], p['s5_c_re'], p['s5_c_im'], p['s5_d'],
                         p['s5_w_glu'], need_ctx_out)

    y_d, y_dc = natten_mixer(heads(dq, D_HEADS), heads(dk, D_HEADS), heads(dv, D_HEADS),
                             heads(dqc, D_HEADS) if need_ctx_out else None,
                             heads(dkc, D_HEADS), heads(dvc, D_HEADS), p['na_rpb'])

    y = group_rmsnorm(jnp.concatenate([y_a, y_b, y_s, y_d], axis=-1), p['mix_norm_g']) @ p['w_out']
    yc = None
    if need_ctx_out:
        yc = group_rmsnorm(jnp.concatenate([y_ac, y_bc, y_sc, y_dc], axis=-1), p['mix_norm_g']) @ p['w_out']
    return y, yc


def peer_ffn(h, w_q, sub_keys, u_tab, v_tab):
    shp = h.shape
    t = h.reshape(-1, shp[-1])
    n = t.shape[0]
    half = PEER_DKEY // 2
    q = (t @ w_q).reshape(n, PEER_HEADS, 2, half)
    s1 = jnp.einsum('nhd,kd->nhk', q[:, :, 0], sub_keys[0]).astype(jnp.float32)
    s2 = jnp.einsum('nhd,kd->nhk', q[:, :, 1], sub_keys[1]).astype(jnp.float32)
    v1, i1 = lax.top_k(s1, PEER_TOPK)
    v2, i2 = lax.top_k(s2, PEER_TOPK)
    cand_s = (v1[..., :, None] + v2[..., None, :]).reshape(n, PEER_HEADS, PEER_TOPK * PEER_TOPK)
    cand_i = (i1[..., :, None] * PEER_NKEYS + i2[..., None, :]).reshape(n, PEER_HEADS, PEER_TOPK * PEER_TOPK)
    top_s, pos = lax.top_k(cand_s, PEER_TOPK)
    idx = jnp.take_along_axis(cand_i, pos, axis=-1)
    gate = jax.nn.softmax(top_s, axis=-1)
    nc = n // PEER_CHUNK

    def expert_chunk(args):
        tc, ic, gc = args
        act = jax.nn.gelu(jnp.einsum('cd,chkd->chk', tc, u_tab[ic]))
        w = gc.astype(act.dtype) * act
        return jnp.einsum('chk,chkd->cd', w.astype(v_tab.dtype), v_tab[ic])

    o = lax.map(expert_chunk, (t.reshape(nc, PEER_CHUNK, shp[-1]),
                               idx.reshape(nc, PEER_CHUNK, PEER_HEADS, PEER_TOPK),
                               gate.reshape(nc, PEER_CHUNK, PEER_HEADS, PEER_TOPK)))
    return o.reshape(shp).astype(h.dtype)


def hybrid_layer(x, xc, c, c_ctx, row_pos, col_pos, p, update_ctx):
    mod = jax.nn.silu(c) @ p['w_ada'] + p['b_ada']
    sh1, sc1, g1, sh2, sc2, g2 = [m[:, None, :] for m in jnp.split(mod, 6, axis=-1)]
    modc = jax.nn.silu(c_ctx) @ p['w_ada'] + p['b_ada']
    sh1c, sc1c, g1c, sh2c, sc2c, g2c = jnp.split(modc, 6, axis=-1)
    h = modulate(x, p['norm1_g'], sh1, sc1)
    hc = modulate(xc, p['norm1_g'], sh1c, sc1c)
    y, yc = token_mixers(h, hc, row_pos, col_pos, p, update_ctx)
    x = x + g1 * y
    x = x + g2 * peer_ffn(modulate(x, p['norm2_g'], sh2, sc2), p['peer_w_q'], p['peer_sub_keys'], p['peer_u'], p['peer_v'])
    if update_ctx:
        xc = xc + g1c * yc
        xc = xc + g2c * peer_ffn(modulate(xc, p['norm2_g'], sh2c, sc2c), p['peer_w_q'], p['peer_sub_keys'], p['peer_u'], p['peer_v'])
    return x, xc


def setup_inputs(seed: int = 0) -> dict:
    key = jax.random.key(seed)
    ks = iter(jax.random.split(key, 40))

    def nrm(shape, s):
        return jax.random.normal(next(ks), shape, jnp.float32) * s

    G, P, CG = C_NGROUPS, C_STATE, C_GROUP
    x = nrm((BATCH, SEQ, D_MODEL), 1.0)
    c = nrm((BATCH, D_MODEL), 1.0)
    ctx = nrm((BATCH, CTX_LEN, D_MODEL), 1.0)
    c_ctx = nrm((D_MODEL,), 1.0)
    norm1_g = 1.0 + nrm((DEPTH, D_MODEL), 0.02)
    norm2_g = 1.0 + nrm((DEPTH, D_MODEL), 0.02)
    w_ada = nrm((DEPTH, D_MODEL, 6 * D_MODEL), 0.5 * D_MODEL ** -0.5)
    b_ada = nrm((DEPTH, 6 * D_MODEL), 0.02)
    w_in = nrm((DEPTH, D_MODEL, IN_WIDTH), D_MODEL ** -0.5)
    swa_sink = nrm((DEPTH, A_HEADS), 0.5)
    mla_q_norm_g = 1.0 + nrm((DEPTH, B_Q_LORA), 0.02)
    mla_w_uq = nrm((DEPTH, B_Q_LORA, B_HEADS * (B_NOPE + B_ROPE)), B_Q_LORA ** -0.5)
    mla_kv_norm_g = 1.0 + nrm((DEPTH, B_KV_LORA), 0.02)
    mla_w_ukv = nrm((DEPTH, B_KV_LORA, B_HEADS * (B_NOPE + B_VDIM)), B_KV_LORA ** -0.5)
    s5_lambda_re = -0.5 * jnp.exp(nrm((DEPTH, 2, G, P), 0.02))
    s5_lambda_im = math.pi * jnp.arange(P, dtype=jnp.float32) + nrm((DEPTH, 2, G, P), 0.01)
    s5_log_step = math.log(STEP_MIN) + jax.random.uniform(next(ks), (DEPTH, 2, G), jnp.float32) * (math.log(STEP_MAX) - math.log(STEP_MIN))
    s5_b_re = nrm((DEPTH, 2, G, P, CG), (2 * CG) ** -0.5)
    s5_b_im = nrm((DEPTH, 2, G, P, CG), (2 * CG) ** -0.5)
    s5_c_re = nrm((DEPTH, 2, G, CG, P), (2 * P) ** -0.5)
    s5_c_im = nrm((DEPTH, 2, G, CG, P), (2 * P) ** -0.5)
    s5_d = nrm((DEPTH, C_CH), 1.0)
    s5_w_glu = nrm((DEPTH, C_CH, 2 * C_CH), C_CH ** -0.5)
    na_rpb = nrm((DEPTH, D_HEADS, 2 * NA_KH - 1, 2 * NA_KW - 1), 0.1)
    mix_norm_g = 1.0 + nrm((DEPTH, D_MIX), 0.02)
    w_out = nrm((DEPTH, D_MIX, D_MODEL), D_MIX ** -0.5)
    peer_w_q = nrm((DEPTH, D_MODEL, PEER_HEADS * PEER_DKEY), D_MODEL ** -0.5)
    peer_sub_keys = nrm((DEPTH, 2, PEER_NKEYS, PEER_DKEY // 2), (PEER_DKEY // 2) ** -0.5)
    peer_u = nrm((DEPTH, PEER_NEXPERTS, D_MODEL), D_MODEL ** -0.5)
    peer_v = nrm((DEPTH, PEER_NEXPERTS, D_MODEL), 1.0)
    final_norm_g = 1.0 + nrm((D_MODEL,), 0.02)
    return {'x': x, 'c': c, 'ctx': ctx, 'c_ctx': c_ctx,
            'norm1_g': norm1_g, 'norm2_g': norm2_g, 'w_ada': w_ada, 'b_ada': b_ada, 'w_in': w_in,
            'swa_sink': swa_sink,
            'mla_q_norm_g': mla_q_norm_g, 'mla_w_uq': mla_w_uq, 'mla_kv_norm_g': mla_kv_norm_g, 'mla_w_ukv': mla_w_ukv,
            's5_lambda_re': s5_lambda_re, 's5_lambda_im': s5_lambda_im, 's5_log_step': s5_log_step,
            's5_b_re': s5_b_re, 's5_b_im': s5_b_im, 's5_c_re': s5_c_re, 's5_c_im': s5_c_im,
            's5_d': s5_d, 's5_w_glu': s5_w_glu,
            'na_rpb': na_rpb, 'mix_norm_g': mix_norm_g, 'w_out': w_out,
            'peer_w_q': peer_w_q, 'peer_sub_keys': peer_sub_keys, 'peer_u': peer_u, 'peer_v': peer_v,
            'final_norm_g': final_norm_g}


def reference(x, c, ctx, c_ctx, norm1_g, norm2_g, w_ada, b_ada, w_in, swa_sink,
              mla_q_norm_g, mla_w_uq, mla_kv_norm_g, mla_w_ukv,
              s5_lambda_re, s5_lambda_im, s5_log_step, s5_b_re, s5_b_im, s5_c_re, s5_c_im, s5_d, s5_w_glu,
              na_rpb, mix_norm_g, w_out, peer_w_q, peer_sub_keys, peer_u, peer_v, final_norm_g):
    L = x.shape[1]
    t = jnp.arange(L)
    row_pos = t // GRID_W
    col_pos = t % GRID_W
    xc = ctx
    for l in range(DEPTH):
        p = {'norm1_g': norm1_g[l], 'norm2_g': norm2_g[l], 'w_ada': w_ada[l], 'b_ada': b_ada[l],
             'w_in': w_in[l], 'swa_sink': swa_sink[l],
             'mla_q_norm_g': mla_q_norm_g[l], 'mla_w_uq': mla_w_uq[l],
             'mla_kv_norm_g': mla_kv_norm_g[l], 'mla_w_ukv': mla_w_ukv[l],
             's5_lambda_re': s5_lambda_re[l], 's5_lambda_im': s5_lambda_im[l], 's5_log_step': s5_log_step[l],
             's5_b_re': s5_b_re[l], 's5_b_im': s5_b_im[l], 's5_c_re': s5_c_re[l], 's5_c_im': s5_c_im[l],
             's5_d': s5_d[l], 's5_w_glu': s5_w_glu[l],
             'na_rpb': na_rpb[l], 'mix_norm_g': mix_norm_g[l], 'w_out': w_out[l],
             'peer_w_q': peer_w_q[l], 'peer_sub_keys': peer_sub_keys[l], 'peer_u': peer_u[l], 'peer_v': peer_v[l]}
        x, xc = hybrid_layer(x, xc, c, c_ctx, row_pos, col_pos, p, update_ctx=(l < DEPTH - 1))
    return rmsnorm(x, final_norm_g)
```

```cpp
#include <hip/hip_runtime.h>
#include <hip/hip_bf16.h>
#include <hip/hip_cooperative_groups.h>
#include <cstdio>
#include <cstdint>
namespace cg = cooperative_groups;

typedef unsigned short u16;
typedef __attribute__((ext_vector_type(8))) short bf16x8;
typedef __attribute__((ext_vector_type(4))) float f32x4;
typedef __attribute__((ext_vector_type(16))) float f32x16;
typedef __attribute__((ext_vector_type(4))) unsigned u32x4;
typedef __attribute__((ext_vector_type(2))) unsigned u32x2;
typedef __attribute__((ext_vector_type(2))) __bf16 bf16x2_t;

#define NT 256
#ifndef DEBUG_CHECKS
#define DEBUG_CHECKS 0
#endif
#define DEBUG_LAYER 0
#define REP_PHASE 0
#define ATT_DUP 0
#define REP_SUB 0
#define NAN_POISON 0
#define PEER_SIMPLE 0
#define PEER_OLD 0
#define DEBUG_SEL 2
#define DEBUG_TOL 0.08f
#define DEBUG_ONE 13
constexpr int NB = 8, SEQL = 4096, CTXL = 256, LK = 4352, DM = 1024;
constexpr int NLAT = NB * SEQL, NCTX = NB * CTXL, MTOT = NLAT + NCTX;
constexpr int NWIN = 1920;
constexpr float LOG2E = 1.4426950408889634f;
constexpr float EPSN = 1e-6f;
constexpr int SMEM_BYTES = 76800;

constexpr size_t al256(size_t x) { return (x + 255) / 256 * 256; }
constexpr size_t OFF_WINT = 0;
constexpr size_t OFF_WUQT = OFF_WINT + al256((size_t)2 * NWIN * 1024 * 2);
constexpr size_t OFF_WUKVT = OFF_WUQT + al256((size_t)2 * 384 * 192 * 2);
constexpr size_t OFF_WGLUT = OFF_WUKVT + al256((size_t)2 * 512 * 128 * 2);
constexpr size_t OFF_WOUTT = OFF_WGLUT + al256((size_t)2 * 512 * 256 * 2);
constexpr size_t OFF_WQT = OFF_WOUTT + al256((size_t)2 * 1024 * 1024 * 2);
constexpr size_t OFF_SUBK = OFF_WQT + al256((size_t)2 * 2048 * 1024 * 2);
constexpr size_t OFF_UB = OFF_SUBK + al256((size_t)2 * 2 * 128 * 128 * 2);
constexpr size_t OFF_VB = OFF_UB + al256((size_t)16384 * 1024 * 2);
constexpr size_t OFF_MODP = OFF_VB + al256((size_t)16384 * 1024 * 2);
constexpr size_t OFF_MOD = OFF_MODP + al256((size_t)2 * 8 * 9 * 6144 * 4);
constexpr size_t OFF_ROPE16 = OFF_MOD + al256((size_t)2 * 9 * 6144 * 4);
constexpr size_t OFF_ROPE8 = OFF_ROPE16 + al256((size_t)64 * 16 * 8);
constexpr size_t OFF_APOW = OFF_ROPE8 + al256((size_t)64 * 8 * 8);
constexpr size_t OFF_BBAR = OFF_APOW + al256((size_t)2 * 2 * 16 * 64 * 65 * 8);
constexpr size_t OFF_KTAB = OFF_BBAR + al256((size_t)2 * 2 * 16 * 64 * 16 * 8);
constexpr size_t OFF_W1 = OFF_KTAB + al256((size_t)2 * 16 * 2 * 64 * 256 * 4);
constexpr size_t OFF_M3 = OFF_W1 + al256((size_t)2 * 2 * 16 * 128 * 1024 * 2);
constexpr size_t OFF_H = OFF_M3 + al256((size_t)16 * 1024 * 1280 * 2);
constexpr size_t OFF_MIX = OFF_H + al256((size_t)MTOT * 1024 * 2);
constexpr size_t OFF_QA = OFF_MIX;
constexpr size_t OFF_KA = OFF_QA + al256((size_t)NB * 4 * LK * 64 * 2);
constexpr size_t OFF_VTA = OFF_KA + al256((size_t)NB * 2 * LK * 64 * 2);
constexpr size_t OFF_CQ = OFF_VTA + al256((size_t)NB * 2 * LK * 64 * 2);
constexpr size_t OFF_CKV = OFF_CQ + al256((size_t)MTOT * 192 * 2);
constexpr size_t OFF_QB = OFF_CKV + al256((size_t)MTOT * 128 * 2);
constexpr size_t OFF_KB = OFF_QB + al256((size_t)NB * 4 * LK * 96 * 2);
constexpr size_t OFF_VTB = OFF_KB + al256((size_t)NB * 4 * LK * 96 * 2);
constexpr size_t OFF_U5 = OFF_VTB + al256((size_t)NB * 4 * LK * 64 * 2);
constexpr size_t OFF_QD = OFF_U5 + al256((size_t)MTOT * 256 * 2);
constexpr size_t OFF_KD = OFF_QD + al256((size_t)NB * 4 * LK * 64 * 2);
constexpr size_t OFF_VTD = OFF_KD + al256((size_t)NB * 4 * LK * 64 * 2);
constexpr size_t OFF_MIXEND = OFF_VTD + al256((size_t)NB * 4 * LK * 64 * 2);
constexpr size_t OFF_QPEER = OFF_MIX;
constexpr size_t QPEER_END = OFF_QPEER + al256((size_t)MTOT * 2048 * 2);
constexpr size_t OFF_S5S = (OFF_MIXEND > QPEER_END ? OFF_MIXEND : QPEER_END);
constexpr size_t OFF_HIN = OFF_S5S + al256((size_t)544 * 16 * 2 * 128 * 4);
constexpr size_t OFF_YG = OFF_HIN + al256((size_t)544 * 16 * 256 * 2);
constexpr size_t OFF_XC = OFF_YG + al256((size_t)MTOT * 256 * 2);
constexpr size_t OFF_IDX = OFF_XC + al256((size_t)NCTX * 1024 * 4);
constexpr size_t OFF_GATE = OFF_IDX + al256((size_t)MTOT * 128 * 4);
constexpr size_t OFF_BAR = OFF_GATE + al256((size_t)MTOT * 128 * 4);
constexpr size_t BAR_BYTES = 16384;
constexpr size_t WS_TOTAL = OFF_BAR + BAR_BYTES;

struct Params {
  const float* in[31];
  float* out;
  unsigned char* ws;
};
typedef const __attribute__((address_space(4))) Params* KP;
enum { I_X = 0, I_C, I_CTX, I_CCTX, I_N1G, I_N2G, I_WADA, I_BADA, I_WIN, I_SINK, I_QNG, I_WUQ, I_KVNG, I_WUKV,
       I_LRE, I_LIM, I_LSTEP, I_BRE, I_BIM, I_CRE, I_CIM, I_S5D, I_WGLU, I_RPB, I_MIXG, I_WOUT, I_PWQ, I_SUBK, I_PU, I_PV, I_FNG };

__device__ __forceinline__ int tidx() { int t = threadIdx.x; asm volatile("" : "+v"(t)); return t; }
__device__ __forceinline__ int bidx() { int b = blockIdx.x; asm volatile("" : "+s"(b)); return b; }
__device__ __forceinline__ u16 f2bf(float f) { __hip_bfloat16 b = __float2bfloat16(f); return *reinterpret_cast<u16*>(&b); }
__device__ __forceinline__ float bf2f(u16 v) { return __uint_as_float(((unsigned)v) << 16); }
typedef __attribute__((ext_vector_type(2))) float f32x2_;
typedef __attribute__((ext_vector_type(2))) __bf16 bf16x2v_;
__device__ __forceinline__ unsigned pack2(float lo, float hi) { const f32x2_ v = {lo, hi}; return __builtin_bit_cast(unsigned, __builtin_convertvector(v, bf16x2v_)); }
__device__ __forceinline__ float gelu_tanh(float x) {
  const float u = 0.7978845608028654f * (x + 0.044715f * x * x * x);
  const float e = __expf(2.0f * u);
  const float t = 1.0f - 2.0f / (e + 1.0f);
  return 0.5f * x * (1.0f + t);
}
__device__ __forceinline__ float sigmoidf_(float x) { return 1.0f / (1.0f + __expf(-x)); }
__device__ __forceinline__ void row_btk(int r, int& b, int& tk) {
  if (r < NLAT) { b = r >> 12; tk = r & 4095; } else { const int q = r - NLAT; b = q >> 8; tk = 4096 + (q & 255); }
}
__device__ __forceinline__ f32x4 mfma16(bf16x8 a, bf16x8 b, f32x4 c) { return __builtin_amdgcn_mfma_f32_16x16x32_bf16(a, b, c, 0, 0, 0); }
__device__ __forceinline__ f32x16 mfma32(bf16x8 a, bf16x8 b, f32x16 c) { return __builtin_amdgcn_mfma_f32_32x32x16_bf16(a, b, c, 0, 0, 0); }
__device__ __forceinline__ float wave_sum(float v) {
#pragma unroll
  for (int o = 32; o >= 1; o >>= 1) v += __shfl_xor(v, o);
  return v;
}
__device__ __forceinline__ float2 cmul(float2 a, float2 b) { return make_float2(a.x * b.x - a.y * b.y, a.x * b.y + a.y * b.x); }


#define XB_TMO      128
#define XB_XCNT(j)  (256  + 64 * (j))
#define XB_XSUB(j)  (1280 + 64 * (j))
#define XB_XGEN(j)  (2304 + 64 * (j))
#define XB_TOP      3328
#define XB_TOPGEN   3392
#define XB_SPIN_CAP (1u << 22)
#define LAS __attribute__((address_space(3)))
__device__ __forceinline__ unsigned xb_ld(unsigned* p) { return __hip_atomic_load(p, __ATOMIC_RELAXED, __HIP_MEMORY_SCOPE_AGENT); }
__device__ __forceinline__ unsigned xb_add(unsigned* p, unsigned v) { return __hip_atomic_fetch_add(p, v, __ATOMIC_RELAXED, __HIP_MEMORY_SCOPE_AGENT); }
__device__ __forceinline__ unsigned xb_xcc_id() { return (unsigned)__builtin_amdgcn_s_getreg((3 << 11) | 20) & 0xFu; }
#define XB_SPIN(cond, bar) do { unsigned _sp = 0; while (cond) { __builtin_amdgcn_s_sleep(1); \
    if ((++_sp & 255u) == 0u) { if (xb_ld(&(bar)[XB_TMO])) break; if (_sp > XB_SPIN_CAP) { atomicAdd(&(bar)[XB_TMO], 1u); break; } } } } while (0)
__device__ __forceinline__ void xcd_barrier_complete(unsigned* bar, unsigned x, unsigned& nloc, unsigned& nx) {
  const unsigned G = gridDim.x;
  unsigned sum, cnt, mine, sp = 0u;
  for (;;) {
    sum = 0u; cnt = 0u; mine = 0u;
#pragma unroll
    for (unsigned j = 0; j < 16; ++j) { const unsigned c = xb_ld(&bar[XB_XCNT(j)]); sum += c; cnt += (c > 0u) ? 1u : 0u; mine = (j == x) ? c : mine; }
    if (sum == G) break;
    __builtin_amdgcn_s_sleep(1);
    if ((++sp & 255u) == 0u) { if (xb_ld(&bar[XB_TMO])) break; if (sp > XB_SPIN_CAP) { atomicAdd(&bar[XB_TMO], 1u); break; } }
  }
  nloc = mine > 0u ? mine : 1u; nx = cnt > 0u ? cnt : 1u;
}
__device__ __forceinline__ void xcd_barrier(unsigned* bar, volatile LAS unsigned* st) {
  asm volatile("s_waitcnt vmcnt(0)" ::: "memory");
  __syncthreads();
  if (threadIdx.x == 0) {
    const unsigned x = xb_xcc_id();
    __builtin_amdgcn_s_waitcnt(0);
    unsigned nloc = st[0], nx = st[1];
    if (nloc == 0u) { xcd_barrier_complete(bar, x, nloc, nx); st[0] = nloc; st[1] = nx; }
    const unsigned old = xb_add(&bar[XB_XSUB(x)], 1u);
    const unsigned gen = old / nloc;
    if (old + 1u == (gen + 1u) * nloc) {
      __builtin_amdgcn_fence(__ATOMIC_RELEASE, "agent");
      asm volatile("s_waitcnt vmcnt(0)" ::: "memory");
      const unsigned og = xb_add(&bar[XB_TOP], 1u);
      const unsigned tg = og / nx;
      if (og + 1u == (tg + 1u) * nx) xb_add(&bar[XB_TOPGEN], 1u);
      else XB_SPIN(xb_ld(&bar[XB_TOPGEN]) == tg, bar);
      __builtin_amdgcn_fence(__ATOMIC_ACQUIRE, "agent");
      xb_add(&bar[XB_XGEN(x)], 1u);
      asm volatile("s_waitcnt vmcnt(0)" ::: "memory");
    } else {
      XB_SPIN(xb_ld(&bar[XB_XGEN(x)]) == gen, bar);
      __builtin_amdgcn_fence(__ATOMIC_ACQUIRE, "agent");
      asm volatile("s_waitcnt vmcnt(0)" ::: "memory");
    }
  }
  __syncthreads();
}
__device__ __forceinline__ void transpose_tile(const float* __restrict__ src, int K, int N, u16* __restrict__ dst, int kt, int nt, int mapmode,
                               const float* __restrict__ kscale, unsigned char* smem, int kb_rows = 0) {
  float* tile = (float*)smem;
  const int tid = tidx();
  __syncthreads();
  {
    const int nn = tid & 63;
    const int np = nt * 64 + nn;
    int n;
    if (mapmode == 1) n = (np < 864) ? np : (np < 896 ? -1 : np - 32);
    else if (mapmode == 2) { const int blk = np >> 5, w = np & 31; n = (w < 16) ? (blk * 16 + w) : (256 + blk * 16 + (w - 16)); }
    else n = np;
#pragma unroll
    for (int i = 0; i < 16; ++i) {
      const int kk = i * 4 + (tid >> 6);
      const int k = kt * 64 + kk;
      float v = 0.f;
      if (n >= 0 && k < K) v = src[(size_t)k * N + n];
      tile[kk * 65 + nn] = v;
    }
  }
  __syncthreads();
  {
    const int kk = tid & 63;
    const int k = kt * 64 + kk;
    if (k < K) {
      const float sc = kscale ? kscale[k] : 1.0f;
#pragma unroll
      for (int i = 0; i < 16; ++i) {
        const int nn = i * 4 + (tid >> 6);
        const size_t di = kb_rows ? (((size_t)(k >> 5) * kb_rows + (nt * 64 + nn)) * 32 + (k & 31)) : ((size_t)(nt * 64 + nn) * K + k);
        dst[di] = f2bf(tile[kk * 65 + nn] * sc);
      }
    }
  }
}

__device__ __forceinline__ float2 apow_calc(float lr, float li, float step, int m) {
  const float mag = __expf(lr * step * (float)m);
  double rev = (double)li * (double)step * (double)m * 0.15915494309189535;
  rev -= rint(rev);
  const float r = (float)rev;
  return make_float2(mag * __builtin_amdgcn_cosf(r), mag * __builtin_amdgcn_sinf(r));
}

__device__ __forceinline__ void phase0(KP kp, unsigned char* smem) {
  unsigned char* ws = kp->ws;
  const int tid = tidx();
  constexpr int N_ADA = 2 * 96;
  constexpr int N_WIN = 2 * 30 * 16;
  constexpr int N_WOUT = 2 * 16 * 16;
  constexpr int N_WQ = 2 * 32 * 16;
  constexpr int N_WUQ = 2 * 6 * 3;
  constexpr int N_WUKV = 2 * 8 * 2;
  constexpr int N_WGLU = 2 * 8 * 4;
  constexpr int N_SUBK = 256;
  constexpr int N_APOW = 1040;
  constexpr int N_BBAR = 256;
  constexpr int N_ROPE = 6;
  constexpr int E0 = N_ADA, E1 = E0 + N_WIN, E2 = E1 + N_WOUT, E3 = E2 + N_WQ, E4 = E3 + N_WUQ, E5 = E4 + N_WUKV,
                E6 = E5 + N_WGLU, E7 = E6 + N_SUBK, E8 = E7 + N_APOW, E9 = E8 + N_BBAR, E10 = E9 + N_ROPE;
  for (int item = bidx(); item < E10; item += gridDim.x) {
    if (item < E0) {
      const int l = item / 96, cb = item % 96;
      float* sl = (float*)smem;
      float* red = (float*)(smem + 9 * 1024 * 4);
      __syncthreads();
      for (int i = tid; i < 9 * 1024; i += NT) {
        const int b = i >> 10, kk = i & 1023;
        const float v = (b < 8) ? kp->in[I_C][b * 1024 + kk] : kp->in[I_CCTX][kk];
        sl[i] = v / (1.0f + __expf(-v));
      }
      __syncthreads();
      const int kq = tid >> 6, cl = tid & 63;
      const int n = cb * 64 + cl;
      float acc[9];
#pragma unroll
      for (int b = 0; b < 9; ++b) acc[b] = 0.f;
      const float* w = kp->in[I_WADA] + (size_t)l * 1024 * 6144 + (size_t)(kq * 256) * 6144 + n;
#pragma unroll 16
      for (int kk = 0; kk < 256; ++kk) {
        const float wv = w[(size_t)kk * 6144];
#pragma unroll
        for (int b = 0; b < 9; ++b) acc[b] += sl[b * 1024 + kq * 256 + kk] * wv;
      }
#pragma unroll
      for (int b = 0; b < 9; ++b) red[(kq * 9 + b) * 64 + cl] = acc[b];
      __syncthreads();
      float* mod = (float*)(ws + OFF_MOD);
      for (int i = tid; i < 9 * 64; i += NT) {
        const int b = i >> 6, c2 = i & 63;
        const float v = red[(0 * 9 + b) * 64 + c2] + red[(1 * 9 + b) * 64 + c2] + red[(2 * 9 + b) * 64 + c2] + red[(3 * 9 + b) * 64 + c2];
        mod[(size_t)(l * 9 + b) * 6144 + cb * 64 + c2] = v + kp->in[I_BADA][l * 6144 + cb * 64 + c2];
      }
    } else if (item < E1) {
      const int it = item - E0, l = it / 480, r = it % 480, nt = r / 16, kt = r % 16;
      transpose_tile(kp->in[I_WIN] + (size_t)l * 1024 * 1888, 1024, 1888, (u16*)(ws + OFF_WINT) + (size_t)l * NWIN * 1024, kt, nt, 1, nullptr, smem, NWIN);
    } else if (item < E2) {
      const int it = item - E1, l = it / 256, r = it % 256, nt = r / 16, kt = r % 16;
      transpose_tile(kp->in[I_WOUT] + (size_t)l * 1024 * 1024, 1024, 1024, (u16*)(ws + OFF_WOUTT) + (size_t)l * 1024 * 1024, kt, nt, 0,
                     kp->in[I_MIXG] + l * 1024, smem, 1024);
    } else if (item < E3) {
      const int it = item - E2, l = it / 512, r = it % 512, nt = r / 16, kt = r % 16;
      transpose_tile(kp->in[I_PWQ] + (size_t)l * 1024 * 2048, 1024, 2048, (u16*)(ws + OFF_WQT) + (size_t)l * 2048 * 1024, kt, nt, 0, nullptr, smem, 2048);
    } else if (item < E4) {
      const int it = item - E3, l = it / 18, r = it % 18, nt = r / 3, kt = r % 3;
      transpose_tile(kp->in[I_WUQ] + (size_t)l * 192 * 384, 192, 384, (u16*)(ws + OFF_WUQT) + (size_t)l * 384 * 192, kt, nt, 0,
                     kp->in[I_QNG] + l * 192, smem);
    } else if (item < E5) {
      const int it = item - E4, l = it / 16, r = it % 16, nt = r / 2, kt = r % 2;
      transpose_tile(kp->in[I_WUKV] + (size_t)l * 128 * 512, 128, 512, (u16*)(ws + OFF_WUKVT) + (size_t)l * 512 * 128, kt, nt, 0,
                     kp->in[I_KVNG] + l * 128, smem);
    } else if (item < E6) {
      const int it = item - E5, l = it / 32, r = it % 32, nt = r / 4, kt = r % 4;
      transpose_tile(kp->in[I_WGLU] + (size_t)l * 256 * 512, 256, 512, (u16*)(ws + OFF_WGLUT) + (size_t)l * 512 * 256, kt, nt, 2, nullptr, smem);
    } else if (item < E7) {
      const int e = (item - E6) * NT + tid;
      ((u16*)(ws + OFF_SUBK))[e] = f2bf(kp->in[I_SUBK][e]);
    } else if (item < E8) {
      const int e = (item - E7) * NT + tid;
      const int m = e % 65, idx4 = e / 65;
      const float lr = kp->in[I_LRE][idx4], li = kp->in[I_LIM][idx4];
      const float step = __expf(kp->in[I_LSTEP][idx4 >> 6]);
      ((float2*)(ws + OFF_APOW))[e] = apow_calc(lr, li, step, m);
    } else if (item < E9) {
      const int e = (item - E8) * NT + tid;
      const int idx4 = e >> 4;
      const float lr = kp->in[I_LRE][idx4], li = kp->in[I_LIM][idx4];
      const float step = __expf(kp->in[I_LSTEP][idx4 >> 6]);
      const float2 ab = apow_calc(lr, li, step, 1);
      const float nr = ab.x - 1.0f, ni = ab.y;
      const float den = lr * lr + li * li;
      const float fr = (nr * lr + ni * li) / den, fi = (ni * lr - nr * li) / den;
      const float br = kp->in[I_BRE][e], bi = kp->in[I_BIM][e];
      ((float2*)(ws + OFF_BBAR))[e] = make_float2(fr * br - fi * bi, fr * bi + fi * br);
    } else {
      const int e = (item - E9) * NT + tid;
      if (e < 1024) {
        const int pos = e >> 4, i = e & 15;
        const float invf = __builtin_amdgcn_exp2f(-(float)i * (13.287712379549449f / 16.0f));
        const float rev = (float)pos * invf * 0.15915494309189535f;
        ((float2*)(ws + OFF_ROPE16))[e] = make_float2(__builtin_amdgcn_cosf(rev), __builtin_amdgcn_sinf(rev));
      } else if (e < 1536) {
        const int q = e - 1024, pos = q >> 3, i = q & 7;
        const float invf = __builtin_amdgcn_exp2f(-(float)i * (13.287712379549449f / 8.0f));
        const float rev = (float)pos * invf * 0.15915494309189535f;
        ((float2*)(ws + OFF_ROPE8))[q] = make_float2(__builtin_amdgcn_cosf(rev), __builtin_amdgcn_sinf(rev));
      }
    }
  }
}

__device__ __forceinline__ void s5_tables(KP kp) {
  unsigned char* ws = kp->ws;
  const int gtid = bidx() * NT + tidx(), gn = gridDim.x * NT;
  const float2* apow = (const float2*)(ws + OFF_APOW);
  const float2* bbar = (const float2*)(ws + OFF_BBAR);
  {
    float* ktab = (float*)(ws + OFF_KTAB);
    for (int e = gtid; e < 2 * 16 * 2 * 64 * 16; e += gn) {
      const int cp = e & 15, m = (e >> 4) & 63, dir = (e >> 10) & 1, g = (e >> 11) & 15, l = e >> 15;
      const int base4 = ((l * 2 + dir) * 16 + g) * 64;
      const int cbase = (((l * 2 + dir) * 16 + g) * 16 + cp) * 64;
      float acc[16];
#pragma unroll
      for (int q = 0; q < 16; ++q) acc[q] = 0.f;
      for (int pp = 0; pp < 64; ++pp) {
        const float2 C = make_float2(kp->in[I_CRE][cbase + pp], kp->in[I_CIM][cbase + pp]);
        const float2 ca = cmul(C, apow[(size_t)(base4 + pp) * 65 + m]);
        const f32x4* bb = (const f32x4*)(bbar + (size_t)(base4 + pp) * 16);
#pragma unroll
        for (int q = 0; q < 8; ++q) {
          const f32x4 b2 = bb[q];
          acc[2 * q] += ca.x * b2[0] - ca.y * b2[1];
          acc[2 * q + 1] += ca.x * b2[2] - ca.y * b2[3];
        }
      }
      f32x4* dst = (f32x4*)(ktab + (size_t)e * 16);
#pragma unroll
      for (int q = 0; q < 4; ++q) { f32x4 o; o[0] = acc[4 * q]; o[1] = acc[4 * q + 1]; o[2] = acc[4 * q + 2]; o[3] = acc[4 * q + 3]; dst[q] = o; }
    }
  }
  {
    u16* w1 = (u16*)(ws + OFF_W1);
    for (int e = gtid; e < 2 * 2 * 16 * 128 * 128; e += gn) {
      const int k0 = (e & 127) * 8, n = (e >> 7) & 127, ldg = e >> 14;
      const int dir = (ldg >> 4) & 1;
      const int pp = n >> 1, ri = n & 1, s = k0 >> 4, ch0 = k0 & 15;
      const int pw = dir ? s : 63 - s;
      const int idx4 = ldg * 64 + pp;
      const float2 a = apow[(size_t)idx4 * 65 + pw];
      const f32x4* bb = (const f32x4*)(bbar + (size_t)idx4 * 16 + ch0);
      float v[8];
#pragma unroll
      for (int q = 0; q < 4; ++q) {
        const f32x4 b2 = bb[q];
        v[2 * q] = ri ? (a.x * b2[1] + a.y * b2[0]) : (a.x * b2[0] - a.y * b2[1]);
        v[2 * q + 1] = ri ? (a.x * b2[3] + a.y * b2[2]) : (a.x * b2[2] - a.y * b2[3]);
      }
      u32x4 pk; pk[0] = pack2(v[0], v[1]); pk[1] = pack2(v[2], v[3]); pk[2] = pack2(v[4], v[5]); pk[3] = pack2(v[6], v[7]);
      *(u32x4*)(w1 + (size_t)e * 8) = pk;
    }
  }
}

constexpr size_t OFF_TT = OFF_M3;
constexpr size_t OFF_ST = OFF_M3 + al256((size_t)16 * 127 * 256 * 2);
__device__ __forceinline__ void m3_expand(KP kp, int layer) {
  unsigned char* ws = kp->ws;
  const int gtid = bidx() * NT + tidx(), gn = gridDim.x * NT;
  const float* ktab = (const float*)(ws + OFF_KTAB) + (size_t)layer * (16 * 2 * 64 * 256);
  const float2* apow = (const float2*)(ws + OFF_APOW);
  u16* tt = (u16*)(ws + OFF_TT);
  u16* st = (u16*)(ws + OFF_ST);
  for (int e = gtid; e < 16 * 127 * 32; e += gn) {
    const int ch0 = (e & 1) * 8, cp = (e >> 1) & 15, d = (e >> 5) % 127, g = (e >> 5) / 127;
    const int m = d - 63;
    float vals[8];
    if (m != 0) {
      const int dir = (m > 0) ? 0 : 1, am = (m > 0) ? m : -m;
      const float* src = ktab + ((((size_t)g * 2 + dir) * 64 + am) * 16 + cp) * 16 + ch0;
#pragma unroll
      for (int q = 0; q < 8; ++q) vals[q] = src[q];
    } else {
      const float* s0 = ktab + ((((size_t)g * 2 + 0) * 64 + 0) * 16 + cp) * 16 + ch0;
      const float* s1 = ktab + ((((size_t)g * 2 + 1) * 64 + 0) * 16 + cp) * 16 + ch0;
      const float dsk = kp->in[I_S5D][layer * 256 + g * 16 + cp];
#pragma unroll
      for (int q = 0; q < 8; ++q) vals[q] = s0[q] + s1[q] + ((ch0 + q == cp) ? dsk : 0.f);
    }
    u32x4 pk;
    pk[0] = pack2(vals[0], vals[1]); pk[1] = pack2(vals[2], vals[3]); pk[2] = pack2(vals[4], vals[5]); pk[3] = pack2(vals[6], vals[7]);
    *(u32x4*)(tt + (((size_t)g * 127 + d) * 16 + cp) * 16 + ch0) = pk;
  }
  for (int e = gtid; e < 16 * 1024 * 32; e += gn) {
    const int kq = e & 31, n = (e >> 5) & 1023, g = e >> 15;
    const int j = n >> 4, cp = n & 15;
    const int kk = kq * 8;
    const int dir = kk >> 7, p0 = (kk & 127) >> 1;
    const int pw = dir ? (64 - j) : (j + 1);
    const int ldg = (layer * 2 + dir) * 16 + g;
    float vals[8];
#pragma unroll
    for (int q = 0; q < 4; ++q) {
      const int pp = p0 + q;
      const int ci = (ldg * 16 + cp) * 64 + pp;
      const float2 C = make_float2(kp->in[I_CRE][ci], kp->in[I_CIM][ci]);
      const float2 z = cmul(C, apow[(size_t)(ldg * 64 + pp) * 65 + pw]);
      vals[2 * q] = z.x; vals[2 * q + 1] = -z.y;
    }
    u32x4 pk;
    pk[0] = pack2(vals[0], vals[1]); pk[1] = pack2(vals[2], vals[3]); pk[2] = pack2(vals[4], vals[5]); pk[3] = pack2(vals[6], vals[7]);
    *(u32x4*)(st + ((size_t)g * 1024 + n) * 256 + kk) = pk;
  }
}

template <bool KBLK = false>
__device__ __forceinline__ void norm_mod_rows(const float* __restrict__ src_lat, const float* __restrict__ src_ctx, const float* __restrict__ g,
                              const float* __restrict__ modl, int sh_off, int sc_off, u16* __restrict__ dst, int nrows) {
  const int lane = tidx() & 63;
  const int gw = (bidx() * NT + tidx()) >> 6, nw = (gridDim.x * NT) >> 6;
  for (int r0 = gw; r0 < nrows; r0 += 2 * nw) {
    f32x4 v[2][4];
    int rr[2];
#pragma unroll
    for (int u = 0; u < 2; ++u) {
      const int r = r0 + u * nw;
      rr[u] = (r < nrows) ? r : r0;
      const float* src = (rr[u] < NLAT) ? (src_lat + (size_t)rr[u] * 1024) : (src_ctx + (size_t)(rr[u] - NLAT) * 1024);
#pragma unroll
      for (int i = 0; i < 4; ++i) v[u][i] = *(const f32x4*)(src + i * 256 + lane * 4);
    }
#pragma unroll
    for (int u = 0; u < 2; ++u) {
      const int r = r0 + u * nw;
      if (r >= nrows) break;
      const int bb = (r < NLAT) ? (r >> 12) : 8;
      float ss = 0.f;
#pragma unroll
      for (int i = 0; i < 4; ++i) ss += v[u][i][0] * v[u][i][0] + v[u][i][1] * v[u][i][1] + v[u][i][2] * v[u][i][2] + v[u][i][3] * v[u][i][3];
      ss = wave_sum(ss);
      const float rstd = rsqrtf(ss * (1.0f / 1024.0f) + EPSN);
      const float* mrow = modl + (size_t)bb * 6144;
#pragma unroll
      for (int i = 0; i < 4; ++i) {
        const int c = i * 256 + lane * 4;
        const f32x4 gg = *(const f32x4*)(g + c);
        const f32x4 sh = *(const f32x4*)(mrow + sh_off + c);
        const f32x4 sc = *(const f32x4*)(mrow + sc_off + c);
        float o[4];
#pragma unroll
        for (int j = 0; j < 4; ++j) o[j] = v[u][i][j] * rstd * gg[j] * (1.0f + sc[j]) + sh[j];
        u32x2 pk; pk[0] = pack2(o[0], o[1]); pk[1] = pack2(o[2], o[3]);
        if (KBLK) *(u32x2*)(dst + ((size_t)(c >> 5) * MTOT + r) * 32 + (c & 31)) = pk;
        else *(u32x2*)(dst + (size_t)r * 1024 + c) = pk;
      }
    }
  }
}

__device__ __forceinline__ void phase1(KP kp, int layer) {
  unsigned char* ws = kp->ws;
  const int gtid = bidx() * NT + tidx(), gn = gridDim.x * NT;
  {
    const f32x4* su = (const f32x4*)(kp->in[I_PU] + (size_t)layer * 16384 * 1024);
    const f32x4* sv = (const f32x4*)(kp->in[I_PV] + (size_t)layer * 16384 * 1024);
    u32x4* du = (u32x4*)(ws + OFF_UB);
    u32x4* dv = (u32x4*)(ws + OFF_VB);
    for (int e = gtid; e < 16384 * 32; e += gn) {
      u32x4 pu, pv;
#pragma unroll
      for (int q = 0; q < 4; ++q) {
        const f32x4 a0 = su[(size_t)e * 8 + 2 * q], a1 = su[(size_t)e * 8 + 2 * q + 1];
        const f32x4 b0 = sv[(size_t)e * 8 + 2 * q], b1 = sv[(size_t)e * 8 + 2 * q + 1];
        unsigned wu = 0, wv = 0;
        wu = __builtin_amdgcn_cvt_scalef32_pk_fp4_f32(wu, a0[0] * 64.0f, a0[1] * 64.0f, 1.0f, 0);
        wu = __builtin_amdgcn_cvt_scalef32_pk_fp4_f32(wu, a0[2] * 64.0f, a0[3] * 64.0f, 1.0f, 1);
        wu = __builtin_amdgcn_cvt_scalef32_pk_fp4_f32(wu, a1[0] * 64.0f, a1[1] * 64.0f, 1.0f, 2);
        wu = __builtin_amdgcn_cvt_scalef32_pk_fp4_f32(wu, a1[2] * 64.0f, a1[3] * 64.0f, 1.0f, 3);
        wv = __builtin_amdgcn_cvt_scalef32_pk_fp4_f32(wv, b0[0] * 2.0f, b0[1] * 2.0f, 1.0f, 0);
        wv = __builtin_amdgcn_cvt_scalef32_pk_fp4_f32(wv, b0[2] * 2.0f, b0[3] * 2.0f, 1.0f, 1);
        wv = __builtin_amdgcn_cvt_scalef32_pk_fp4_f32(wv, b1[0] * 2.0f, b1[1] * 2.0f, 1.0f, 2);
        wv = __builtin_amdgcn_cvt_scalef32_pk_fp4_f32(wv, b1[2] * 2.0f, b1[3] * 2.0f, 1.0f, 3);
        pu[q] = wu; pv[q] = wv;
      }
      du[e] = pu; dv[e] = pv;
    }
  }
  if (layer == 0) s5_tables(kp);
  const float* src_lat = (layer == 0) ? kp->in[I_X] : kp->out;
  const float* src_ctx = (layer == 0) ? kp->in[I_CTX] : (const float*)(ws + OFF_XC);
  norm_mod_rows<true>(src_lat, src_ctx, kp->in[I_N1G] + layer * 1024, (const float*)(ws + OFF_MOD) + (size_t)layer * 9 * 6144, 0, 1024,
                (u16*)(ws + OFF_H), MTOT);
}

template <class Epi>
__device__ __forceinline__ void gemm128(const u16* __restrict__ A, int lda, const u16* __restrict__ BT, int ldb, int K, int m0, int n0,
                                        unsigned char* smem, Epi& epi) {
  const int tid = tidx(), lane = tid & 63, wave = tid >> 6, wm = wave >> 1, wn = wave & 1;
  u16* sA = (u16*)smem;
  u16* sB = (u16*)(smem + 16384);
  f32x4 acc[4][4];
#pragma unroll
  for (int i = 0; i < 4; ++i)
#pragma unroll
    for (int j = 0; j < 4; ++j) acc[i][j] = (f32x4){0.f, 0.f, 0.f, 0.f};
  u32x4 ra[4], rb[4];
  const int lrow = tid >> 3, lc = tid & 7;
  const u16* ga = A + (size_t)(m0 + lrow) * lda + lc * 8;
  const u16* gb = BT + (size_t)(n0 + lrow) * ldb + lc * 8;
#pragma unroll
  for (int i = 0; i < 4; ++i) {
    ra[i] = *(const u32x4*)(ga + (size_t)(32 * i) * lda);
    rb[i] = *(const u32x4*)(gb + (size_t)(32 * i) * ldb);
  }
  for (int k0 = 0; k0 < K; k0 += 64) {
    __syncthreads();
#pragma unroll
    for (int i = 0; i < 4; ++i) {
      const int row = lrow + 32 * i;
      const int off = row * 64 + ((lc ^ (row & 7)) * 8);
      *(u32x4*)(sA + off) = ra[i];
      *(u32x4*)(sB + off) = rb[i];
    }
    __syncthreads();
    if (k0 + 64 < K) {
#pragma unroll
      for (int i = 0; i < 4; ++i) {
        ra[i] = *(const u32x4*)(ga + (size_t)(32 * i) * lda + k0 + 64);
        rb[i] = *(const u32x4*)(gb + (size_t)(32 * i) * ldb + k0 + 64);
      }
    }
#pragma unroll
    for (int ks = 0; ks < 2; ++ks) {
      bf16x8 af[4], bfr[4];
      const int c = ks * 4 + (lane >> 4);
#pragma unroll
      for (int mi = 0; mi < 4; ++mi) {
        const int row = wm * 64 + mi * 16 + (lane & 15);
        af[mi] = *(const bf16x8*)(sA + row * 64 + ((c ^ (row & 7)) * 8));
      }
#pragma unroll
      for (int ni = 0; ni < 4; ++ni) {
        const int row = wn * 64 + ni * 16 + (lane & 15);
        bfr[ni] = *(const bf16x8*)(sB + row * 64 + ((c ^ (row & 7)) * 8));
      }
#pragma unroll
      for (int mi = 0; mi < 4; ++mi)
#pragma unroll
        for (int ni = 0; ni < 4; ++ni) acc[mi][ni] = mfma16(af[mi], bfr[ni], acc[mi][ni]);
    }
  }
  epi(m0 + wm * 64, n0 + wn * 64, acc, lane);
}

template <int BK, class AL, class BL, class Epi>
__device__ __forceinline__ void gemm_t(AL al, BL bl, int K, int row0_out, int col0_out, unsigned char* smem, Epi& epi) {
  constexpr int CH = BK / 8;
  constexpr int NL = CH / 2;
  const int tid = tidx(), lane = tid & 63, wave = tid >> 6, wm = wave >> 1, wn = wave & 1;
  u16* sA = (u16*)smem;
  u16* sB = (u16*)(smem + 128 * BK * 2);
  f32x4 acc[4][4];
#pragma unroll
  for (int i = 0; i < 4; ++i)
#pragma unroll
    for (int j = 0; j < 4; ++j) acc[i][j] = (f32x4){0.f, 0.f, 0.f, 0.f};
  u32x4 ra[NL], rb[NL];
  const int lrow = tid / CH, lc = tid % CH;
  constexpr int RSTEP = 256 / CH;
#pragma unroll
  for (int i = 0; i < NL; ++i) {
    ra[i] = *(const u32x4*)al(lrow + RSTEP * i, lc * 8);
    rb[i] = *(const u32x4*)bl(lrow + RSTEP * i, lc * 8);
  }
  for (int k0 = 0; k0 < K; k0 += BK) {
    __syncthreads();
#pragma unroll
    for (int i = 0; i < NL; ++i) {
      const int row = lrow + RSTEP * i;
      const int off = row * BK + ((lc ^ (row & (CH - 1))) * 8);
      *(u32x4*)(sA + off) = ra[i];
      *(u32x4*)(sB + off) = rb[i];
    }
    __syncthreads();
    if (k0 + BK < K) {
#pragma unroll
      for (int i = 0; i < NL; ++i) {
        ra[i] = *(const u32x4*)al(lrow + RSTEP * i, k0 + BK + lc * 8);
        rb[i] = *(const u32x4*)bl(lrow + RSTEP * i, k0 + BK + lc * 8);
      }
    }
#pragma unroll
    for (int ks = 0; ks < BK / 32; ++ks) {
      bf16x8 af[4], bfr[4];
      const int c = ks * 4 + (lane >> 4);
#pragma unroll
      for (int mi = 0; mi < 4; ++mi) {
        const int row = wm * 64 + mi * 16 + (lane & 15);
        af[mi] = *(const bf16x8*)(sA + row * BK + ((c ^ (row & (CH - 1))) * 8));
      }
#pragma unroll
      for (int ni = 0; ni < 4; ++ni) {
        const int row = wn * 64 + ni * 16 + (lane & 15);
        bfr[ni] = *(const bf16x8*)(sB + row * BK + ((c ^ (row & (CH - 1))) * 8));
      }
#pragma unroll
      for (int mi = 0; mi < 4; ++mi)
#pragma unroll
        for (int ni = 0; ni < 4; ++ni) acc[mi][ni] = mfma16(af[mi], bfr[ni], acc[mi][ni]);
    }
  }
  epi(row0_out + wm * 64, col0_out + wn * 64, acc, lane);
}
template <bool SWAP = false, class AL, class BL, class Epi>
__device__ __forceinline__ void gemm_dma(AL al, BL bl, int K, int row0_out, int col0_out, unsigned char* smem, Epi& epi,
                                         bool prefetched, bool has_next, AL nal, BL nbl) {
  constexpr int BK = 64, CH = 8;
  const int tid = tidx(), lane = tid & 63, wave = tid >> 6, wm = wave >> 1, wn = wave & 1;
  f32x4 acc[4][4];
#pragma unroll
  for (int i = 0; i < 4; ++i)
#pragma unroll
    for (int j = 0; j < 4; ++j) acc[i][j] = (f32x4){0.f, 0.f, 0.f, 0.f};
  const int lrow = tid >> 3, lc = tid & 7;
  auto stage = [&](int buf, int k0) {
    unsigned char* sa = smem + buf * 32768;
    unsigned char* sb = sa + 16384;
#pragma unroll
    for (int i = 0; i < 4; ++i) {
      const int row = lrow + 32 * i;
      const int csrc = (lc ^ (row & 7)) * 8;
      __builtin_amdgcn_global_load_lds((const unsigned*)al(row, k0 + csrc), (__attribute__((address_space(3))) unsigned*)(sa + (tid + 256 * i) * 16), 16, 0, 0);
      __builtin_amdgcn_global_load_lds((const unsigned*)bl(row, k0 + csrc), (__attribute__((address_space(3))) unsigned*)(sb + (tid + 256 * i) * 16), 16, 0, 0);
    }
  };
  auto stage_next = [&]() {
    unsigned char* sa = smem;
    unsigned char* sb = sa + 16384;
#pragma unroll
    for (int i = 0; i < 4; ++i) {
      const int row = lrow + 32 * i;
      const int csrc = (lc ^ (row & 7)) * 8;
      __builtin_amdgcn_global_load_lds((const unsigned*)nal(row, csrc), (__attribute__((address_space(3))) unsigned*)(sa + (tid + 256 * i) * 16), 16, 0, 0);
      __builtin_amdgcn_global_load_lds((const unsigned*)nbl(row, csrc), (__attribute__((address_space(3))) unsigned*)(sb + (tid + 256 * i) * 16), 16, 0, 0);
    }
  };
  const int nt = K / BK;
  if (!prefetched) {
    __syncthreads();
    stage(0, 0);
  }
  for (int t = 0; t < nt; ++t) {
    asm volatile("s_waitcnt vmcnt(0)" ::: "memory");
    __syncthreads();
    if (t + 1 < nt) stage((t + 1) & 1, (t + 1) * BK);
    else if (has_next && (nt & 1) == 0) stage_next();
    const u16* sA = (const u16*)(smem + (t & 1) * 32768);
    const u16* sB = sA + 8192;
#pragma unroll
    for (int ks = 0; ks < 2; ++ks) {
      bf16x8 af[4], bfr[4];
      const int c = ks * 4 + (lane >> 4);
#pragma unroll
      for (int mi = 0; mi < 4; ++mi) {
        const int row = wm * 64 + mi * 16 + (lane & 15);
        af[mi] = *(const bf16x8*)(sA + row * BK + ((c ^ (row & (CH - 1))) * 8));
      }
#pragma unroll
      for (int ni = 0; ni < 4; ++ni) {
        const int row = wn * 64 + ni * 16 + (lane & 15);
        bfr[ni] = *(const bf16x8*)(sB + row * BK + ((c ^ (row & (CH - 1))) * 8));
      }
#pragma unroll
      for (int mi = 0; mi < 4; ++mi)
#pragma unroll
        for (int ni = 0; ni < 4; ++ni) acc[mi][ni] = SWAP ? mfma16(bfr[ni], af[mi], acc[mi][ni]) : mfma16(af[mi], bfr[ni], acc[mi][ni]);
    }
  }
  epi(row0_out + wm * 64, col0_out + wn * 64, acc, lane);
}
template <bool SWAP = false, class AL, class BL, class Epi>
__device__ __forceinline__ void gemm_dma(AL al, BL bl, int K, int row0_out, int col0_out, unsigned char* smem, Epi& epi) {
  gemm_dma<SWAP>(al, bl, K, row0_out, col0_out, smem, epi, false, false, al, bl);
}
template <bool SWAP = false, class AL, class BL, class Epi>
__device__ __forceinline__ void gemm_dma3(AL al, BL bl, int K, int row0_out, int col0_out, unsigned char* smem, Epi& epi) {
  constexpr int BK = 32, STG = 24576;
  const int tid = tidx(), lane = tid & 63, wave = tid >> 6, wm = wave >> 1, wn = wave & 1;
  f32x4 acc[2][4][4];
#pragma unroll
  for (int h = 0; h < 2; ++h)
#pragma unroll
    for (int i = 0; i < 4; ++i)
#pragma unroll
      for (int j = 0; j < 4; ++j) acc[h][i][j] = (f32x4){0.f, 0.f, 0.f, 0.f};
  const int lrow = tid >> 2, lc = tid & 3;
  auto stage = [&](int buf, int k0) {
    unsigned char* sa = smem + buf * STG;
    unsigned char* sb = sa + 16384;
#pragma unroll
    for (int i = 0; i < 4; ++i) {
      const int row = lrow + 64 * i;
      const int csrc = (lc ^ ((row >> 2) & 3)) * 8;
      __builtin_amdgcn_global_load_lds((const unsigned*)al(row, k0 + csrc), (__attribute__((address_space(3))) unsigned*)(sa + (tid + 256 * i) * 16), 16, 0, 0);
    }
#pragma unroll
    for (int i = 0; i < 2; ++i) {
      const int row = lrow + 64 * i;
      const int csrc = (lc ^ ((row >> 2) & 3)) * 8;
      __builtin_amdgcn_global_load_lds((const unsigned*)bl(row, k0 + csrc), (__attribute__((address_space(3))) unsigned*)(sb + (tid + 256 * i) * 16), 16, 0, 0);
    }
  };
  const int nt = K / BK;
  asm volatile("s_waitcnt vmcnt(0)" ::: "memory");
  __syncthreads();
  stage(0, 0);
  stage(1, BK);
  int buf = 0;
  for (int t = 0; t < nt; ++t) {
    if (t + 1 < nt) asm volatile("s_waitcnt vmcnt(6)" ::: "memory");
    else asm volatile("s_waitcnt vmcnt(0)" ::: "memory");
    __builtin_amdgcn_s_barrier();
    asm volatile("" ::: "memory");
    const u16* sA = (const u16*)(smem + buf * STG);
    const u16* sB = sA + 8192;
    const int c = lane >> 4;
    bf16x8 af[8], bfr[4];
#pragma unroll
    for (int ni = 0; ni < 4; ++ni) {
      const int row = wn * 64 + ni * 16 + (lane & 15);
      bfr[ni] = *(const bf16x8*)(sB + row * BK + ((c ^ ((row >> 2) & 3)) * 8));
    }
#pragma unroll
    for (int mi = 0; mi < 8; ++mi) {
      const int row = wm * 128 + mi * 16 + (lane & 15);
      af[mi] = *(const bf16x8*)(sA + row * BK + ((c ^ ((row >> 2) & 3)) * 8));
    }
    __builtin_amdgcn_sched_barrier(0);
    if (t + 2 < nt) stage((buf >= 1) ? buf - 1 : 2, (t + 2) * BK);
    __builtin_amdgcn_sched_barrier(0);
#pragma unroll
    for (int mi = 0; mi < 8; ++mi) {
#pragma unroll
      for (int ni = 0; ni < 4; ++ni)
        acc[mi >> 2][mi & 3][ni] = SWAP ? mfma16(bfr[ni], af[mi], acc[mi >> 2][mi & 3][ni]) : mfma16(af[mi], bfr[ni], acc[mi >> 2][mi & 3][ni]);
      __builtin_amdgcn_sched_barrier(0);
    }
    buf = (buf == 2) ? 0 : buf + 1;
  }
  epi(row0_out + wm * 128, col0_out + wn * 64, acc[0], lane);
  epi(row0_out + wm * 128 + 64, col0_out + wn * 64, acc[1], lane);
}
struct LoadKB {
  const u16* base; int nrows;
  __device__ __forceinline__ const u16* operator()(int r, int k) const { return base + ((size_t)(k >> 5) * nrows + r) * 32 + (k & 31); }
};
struct LoadRows {
  const u16* base; int ld;
  __device__ __forceinline__ const u16* operator()(int r, int k) const { return base + (size_t)r * ld + k; }
};

__device__ __forceinline__ bool xcd_tile(int bid, int nblk, int round, int MT, int NTN, int& mt, int& nt) {
  const int x = bid & 7, per = nblk >> 3;
  int li = (bid >> 3) + per * round;
  const int mloc = MT >> 3;
  for (int g0 = 0; g0 < NTN; g0 += 8) {
    const int gw = (NTN - g0 < 8) ? (NTN - g0) : 8;
    const int size = mloc * gw;
    if (li < size) { mt = x * mloc + li / gw; nt = g0 + li % gw; return true; }
    li -= size;
  }
  return false;
}
struct EpiG1T {
  unsigned char* ws;
  __device__ __forceinline__ void operator()(int row0, int col0, f32x4 (&acc)[4][4], int lane) const {
    const float2* rope16 = (const float2*)(ws + OFF_ROPE16);
    const float2* rope8 = (const float2*)(ws + OFF_ROPE8);
    const bool is_lat = row0 < NLAT;
    const int cl = lane & 15, rq = lane >> 4;
#pragma unroll
    for (int mi = 0; mi < 4; ++mi) {
      const int r = row0 + mi * 16 + cl;
      int b, tk;
      row_btk(r, b, tk);
      if (col0 < 384 || (col0 >= 1152 && col0 < 1664)) {
        u16* base; int nh, head; float scale = 1.0f; bool rope = false;
        if (col0 < 256) { base = (u16*)(ws + OFF_QA); nh = 4; head = col0 >> 6; scale = 0.125f * LOG2E; rope = is_lat; }
        else if (col0 < 384) { base = (u16*)(ws + OFF_KA); nh = 2; head = (col0 - 256) >> 6; rope = is_lat; }
        else if (col0 < 1408) { base = (u16*)(ws + OFF_QD); nh = 4; head = (col0 - 1152) >> 6; scale = 0.125f * LOG2E; }
        else { base = (u16*)(ws + OFF_KD); nh = 4; head = (col0 - 1408) >> 6; }
        f32x4 v0 = acc[mi][0], v1 = acc[mi][1], v2 = acc[mi][2], v3 = acc[mi][3];
        if (rope) {
          const f32x4* cr = (const f32x4*)(rope16 + (tk >> 6) * 16 + rq * 4);
          const f32x4* cc = (const f32x4*)(rope16 + (tk & 63) * 16 + rq * 4);
          const f32x4 r01 = cr[0], r23 = cr[1], c01 = cc[0], c23 = cc[1];
          const float rc[4] = {r01[0], r01[2], r23[0], r23[2]}, rs[4] = {r01[1], r01[3], r23[1], r23[3]};
          const float kc[4] = {c01[0], c01[2], c23[0], c23[2]}, ks[4] = {c01[1], c01[3], c23[1], c23[3]};
#pragma unroll
          for (int j = 0; j < 4; ++j) {
            const float a0 = v0[j] * rc[j] - v1[j] * rs[j], a1 = v0[j] * rs[j] + v1[j] * rc[j];
            const float a2 = v2[j] * kc[j] - v3[j] * ks[j], a3 = v2[j] * ks[j] + v3[j] * kc[j];
            v0[j] = a0; v1[j] = a1; v2[j] = a2; v3[j] = a3;
          }
        }
        u16* dst = base + ((size_t)(b * nh + head) * LK + tk) * 64 + rq * 4;
        u32x2 p0, p1, p2, p3;
        p0[0] = pack2(v0[0] * scale, v0[1] * scale); p0[1] = pack2(v0[2] * scale, v0[3] * scale);
        p1[0] = pack2(v1[0] * scale, v1[1] * scale); p1[1] = pack2(v1[2] * scale, v1[3] * scale);
        p2[0] = pack2(v2[0] * scale, v2[1] * scale); p2[1] = pack2(v2[2] * scale, v2[3] * scale);
        p3[0] = pack2(v3[0] * scale, v3[1] * scale); p3[1] = pack2(v3[2] * scale, v3[3] * scale);
        *(u32x2*)(dst) = p0; *(u32x2*)(dst + 16) = p1; *(u32x2*)(dst + 32) = p2; *(u32x2*)(dst + 48) = p3;
      } else if (col0 >= 832 && col0 < 896) {
#pragma unroll
        for (int ni = 0; ni < 2; ++ni) {
          f32x4 x = acc[mi][ni];
          f32x4 other;
#pragma unroll
          for (int j = 0; j < 4; ++j) other[j] = __shfl_xor(x[j], 32);
          if (is_lat) {
            const int pos = (ni == 0) ? (tk >> 6) : (tk & 63);
            const f32x4* cs = (const f32x4*)(rope8 + pos * 8 + (rq & 1) * 4);
            const f32x4 c01 = cs[0], c23 = cs[1];
            const float cc[4] = {c01[0], c01[2], c23[0], c23[2]}, ss[4] = {c01[1], c01[3], c23[1], c23[3]};
#pragma unroll
            for (int j = 0; j < 4; ++j) x[j] = (rq < 2) ? (x[j] * cc[j] - other[j] * ss[j]) : (other[j] * ss[j] + x[j] * cc[j]);
          }
          u32x2 pk; pk[0] = pack2(x[0], x[1]); pk[1] = pack2(x[2], x[3]);
#pragma unroll
          for (int h = 0; h < 4; ++h) *(u32x2*)((u16*)(ws + OFF_KB) + ((size_t)(b * 4 + h) * LK + tk) * 96 + 64 + ni * 16 + rq * 4) = pk;
        }
      } else {
        u16* base; int width, cofs;
        if (col0 < 704) { base = (u16*)(ws + OFF_CQ); width = 192; cofs = col0 - 512; }
        else if (col0 < 832) { base = (u16*)(ws + OFF_CKV); width = 128; cofs = col0 - 704; }
        else { base = (u16*)(ws + OFF_U5); width = 256; cofs = col0 - 896; }
#pragma unroll
        for (int ni = 0; ni < 4; ++ni) {
          u32x2 pk; pk[0] = pack2(acc[mi][ni][0], acc[mi][ni][1]); pk[1] = pack2(acc[mi][ni][2], acc[mi][ni][3]);
          *(u32x2*)(base + (size_t)r * width + cofs + ni * 16 + rq * 4) = pk;
        }
      }
    }
  }
};
struct EpiG1 {
  unsigned char* ws;
  __device__ __forceinline__ void operator()(int row0, int col0, f32x4 (&acc)[4][4], int lane) const {
    const float2* rope16 = (const float2*)(ws + OFF_ROPE16);
    const float2* rope8 = (const float2*)(ws + OFF_ROPE8);
    const bool is_lat = row0 < NLAT;
    const int cl = lane & 15, rq = lane >> 4;
#pragma unroll
    for (int mi = 0; mi < 4; ++mi) {
      const int r0 = row0 + mi * 16 + rq * 4;
      int b, tk0;
      row_btk(r0, b, tk0);
      if (col0 < 384 || (col0 >= 1152 && col0 < 1664)) {
        u16* base; int nh, head; float scale = 1.0f; bool rope = false;
        if (col0 < 256) { base = (u16*)(ws + OFF_QA); nh = 4; head = col0 >> 6; scale = 0.125f * LOG2E; rope = is_lat; }
        else if (col0 < 384) { base = (u16*)(ws + OFF_KA); nh = 2; head = (col0 - 256) >> 6; rope = is_lat; }
        else if (col0 < 1408) { base = (u16*)(ws + OFF_QD); nh = 4; head = (col0 - 1152) >> 6; scale = 0.125f * LOG2E; }
        else { base = (u16*)(ws + OFF_KD); nh = 4; head = (col0 - 1408) >> 6; }
#pragma unroll
        for (int j = 0; j < 4; ++j) {
          const int tk = tk0 + j;
          float v0 = acc[mi][0][j], v1 = acc[mi][1][j], v2 = acc[mi][2][j], v3 = acc[mi][3][j];
          if (rope) {
            const float2 cr = rope16[(tk >> 6) * 16 + cl];
            const float2 cc = rope16[(tk & 63) * 16 + cl];
            const float a0 = v0 * cr.x - v1 * cr.y, a1 = v0 * cr.y + v1 * cr.x;
            const float a2 = v2 * cc.x - v3 * cc.y, a3 = v2 * cc.y + v3 * cc.x;
            v0 = a0; v1 = a1; v2 = a2; v3 = a3;
          }
          u16* dst = base + ((size_t)(b * nh + head) * LK + tk) * 64 + cl;
          dst[0] = f2bf(v0 * scale); dst[16] = f2bf(v1 * scale); dst[32] = f2bf(v2 * scale); dst[48] = f2bf(v3 * scale);
        }
      } else if ((col0 >= 384 && col0 < 512) || col0 >= 1664) {
        u16* base; int nh, head;
        if (col0 < 512) { base = (u16*)(ws + OFF_VTA); nh = 2; head = (col0 - 384) >> 6; }
        else { base = (u16*)(ws + OFF_VTD); nh = 4; head = (col0 - 1664) >> 6; }
#pragma unroll
        for (int ni = 0; ni < 4; ++ni) {
          const int d = ni * 16 + cl;
          u32x2 pk; pk[0] = pack2(acc[mi][ni][0], acc[mi][ni][1]); pk[1] = pack2(acc[mi][ni][2], acc[mi][ni][3]);
          *(u32x2*)(base + ((size_t)(b * nh + head) * 64 + d) * LK + tk0) = pk;
        }
      } else if (col0 >= 832 && col0 < 896) {
#pragma unroll
        for (int ni = 0; ni < 2; ++ni) {
#pragma unroll
          for (int j = 0; j < 4; ++j) {
            const int tk = tk0 + j;
            float x = acc[mi][ni][j];
            const float other = __shfl_xor(x, 8);
            if (is_lat) {
              const int pos = (ni == 0) ? (tk >> 6) : (tk & 63);
              const float2 cs = rope8[pos * 8 + (cl & 7)];
              x = (cl < 8) ? (x * cs.x - other * cs.y) : (other * cs.y + x * cs.x);
            }
            const u16 hv = f2bf(x);
#pragma unroll
            for (int h = 0; h < 4; ++h) ((u16*)(ws + OFF_KB))[((size_t)(b * 4 + h) * LK + tk) * 96 + 64 + ni * 16 + cl] = hv;
          }
        }
      } else {
        u16* base; int width, cofs;
        if (col0 < 704) { base = (u16*)(ws + OFF_CQ); width = 192; cofs = col0 - 512; }
        else if (col0 < 832) { base = (u16*)(ws + OFF_CKV); width = 128; cofs = col0 - 704; }
        else { base = (u16*)(ws + OFF_U5); width = 256; cofs = col0 - 896; }
#pragma unroll
        for (int ni = 0; ni < 4; ++ni)
#pragma unroll
          for (int j = 0; j < 4; ++j) base[(size_t)(r0 + j) * width + cofs + ni * 16 + cl] = f2bf(acc[mi][ni][j]);
      }
    }
  }
};

__device__ __forceinline__ void phase2(KP kp, int layer, unsigned char* smem) {
  m3_expand(kp, layer);
  EpiG1 epi{kp->ws};
  EpiG1T epit{kp->ws};
  const u16* A = (const u16*)(kp->ws + OFF_H);
  const u16* BT = (const u16*)(kp->ws + OFF_WINT) + (size_t)layer * NWIN * 1024;
  constexpr int NTN = NWIN / 128;
  const int bid = bidx(), nblk = gridDim.x;
  {
    for (int r = 0;; ++r) {
      int mt, nt;
      if (!xcd_tile(bid, nblk, r, NLAT / 256, NTN, mt, nt)) break;
      LoadKB al{A + (size_t)mt * 256 * 32, MTOT}, bl{BT + (size_t)nt * 128 * 32, NWIN};
      if (nt == 3 || nt >= 13) gemm_dma3<false>(al, bl, 1024, mt * 256, nt * 128, smem, epi);
      else gemm_dma3<true>(al, bl, 1024, mt * 256, nt * 128, smem, epit);
    }
    {
      const int per = nblk >> 3;
      const int rem = ((NLAT / 256 / 8) * NTN) % per;
      const int j = (rem == 0) ? bid : (((bid >> 3) - rem) * 8 + (bid & 7));
      const int nj = (rem == 0) ? nblk : ((per - rem) * 8);
      if (j >= 0) {
        for (int it = j; it < 16 * NTN; it += nj) {
          const int mt = NLAT / 128 + it / NTN, nt = it % NTN;
          LoadKB al{A + (size_t)mt * 128 * 32, MTOT}, bl{BT + (size_t)nt * 128 * 32, NWIN};
          if (nt == 3 || nt >= 13) gemm_dma<false>(al, bl, 1024, mt * 128, nt * 128, smem, epi);
          else gemm_dma<true>(al, bl, 1024, mt * 128, nt * 128, smem, epit);
        }
      }
    }
  }
}

template <int MI, int NI, class AF, class BF>
__device__ __forceinline__ void wave_mma(f32x4 (&acc)[MI][NI], int ksteps, AF af, BF bf) {
  for (int ks = 0; ks < ksteps; ++ks) {
    bf16x8 a[MI], b[NI];
#pragma unroll
    for (int mi = 0; mi < MI; ++mi) a[mi] = af(mi, ks);
#pragma unroll
    for (int ni = 0; ni < NI; ++ni) b[ni] = bf(ni, ks);
#pragma unroll
    for (int mi = 0; mi < MI; ++mi)
#pragma unroll
      for (int ni = 0; ni < NI; ++ni) acc[mi][ni] = mfma16(a[mi], b[ni], acc[mi][ni]);
  }
}
template <int MI, int NI>
__device__ __forceinline__ void zero_acc(f32x4 (&acc)[MI][NI]) {
#pragma unroll
  for (int i = 0; i < MI; ++i)
#pragma unroll
    for (int j = 0; j < NI; ++j) acc[i][j] = (f32x4){0.f, 0.f, 0.f, 0.f};
}

__device__ __forceinline__ int chunk_row0(int cidx) {
  const int b = cidx / 68, c = cidx % 68;
  return (c < 64) ? (b * 4096 + c * 64) : (NLAT + b * 256 + (c - 64) * 64);
}

struct EpiMlaQ {
  unsigned char* ws; const float* srs;
  int tile_row0;
  __device__ __forceinline__ void operator()(int row0, int col0, f32x4 (&acc)[4][4], int lane) const {
    const float2* rope8 = (const float2*)(ws + OFF_ROPE8);
    const int cl = lane & 15, rq = lane >> 4;
    const bool is_lat = row0 < NLAT;
#pragma unroll
    for (int mi = 0; mi < 4; ++mi) {
      const int r0 = row0 + mi * 16 + rq * 4;
      int b, tk0;
      row_btk(r0, b, tk0);
#pragma unroll
      for (int ni = 0; ni < 4; ++ni) {
        const int t16 = (col0 >> 4) + ni;
        const int head = t16 / 6, sub = t16 % 6;
#pragma unroll
        for (int j = 0; j < 4; ++j) {
          const int tk = tk0 + j;
          float x = acc[mi][ni][j] * srs[r0 + j - tile_row0];
          if (sub >= 4) {
            const float other = __shfl_xor(x, 8);
            if (is_lat) {
              const int pos = (sub == 4) ? (tk >> 6) : (tk & 63);
              const float2 cs = rope8[pos * 8 + (cl & 7)];
              x = (cl < 8) ? (x * cs.x - other * cs.y) : (other * cs.y + x * cs.x);
            }
          }
          ((u16*)(ws + OFF_QB))[((size_t)(b * 4 + head) * LK + tk) * 96 + sub * 16 + cl] = f2bf(x * (0.10206207261596575f * LOG2E));
        }
      }
    }
  }
};
struct EpiMlaKV {
  unsigned char* ws; const float* srs; int tile_row0;
  __device__ __forceinline__ void operator()(int row0, int col0, f32x4 (&acc)[4][4], int lane) const {
    const int cl = lane & 15, rq = lane >> 4;
    const int head = col0 >> 7;
    const bool isv = (col0 & 64) != 0;
#pragma unroll
    for (int mi = 0; mi < 4; ++mi) {
      const int r0 = row0 + mi * 16 + rq * 4;
      int b, tk0;
      row_btk(r0, b, tk0);
      float rs[4];
#pragma unroll
      for (int j = 0; j < 4; ++j) rs[j] = srs[r0 + j - tile_row0];
      if (!isv) {
#pragma unroll
        for (int ni = 0; ni < 4; ++ni)
#pragma unroll
          for (int j = 0; j < 4; ++j)
            ((u16*)(ws + OFF_KB))[((size_t)(b * 4 + head) * LK + tk0 + j) * 96 + ni * 16 + cl] = f2bf(acc[mi][ni][j] * rs[j]);
      } else {
#pragma unroll
        for (int ni = 0; ni < 4; ++ni) {
          u32x2 pk;
          pk[0] = pack2(acc[mi][ni][0] * rs[0], acc[mi][ni][1] * rs[1]);
          pk[1] = pack2(acc[mi][ni][2] * rs[2], acc[mi][ni][3] * rs[3]);
          *(u32x2*)((u16*)(ws + OFF_VTB) + ((size_t)(b * 4 + head) * 64 + ni * 16 + cl) * LK + tk0) = pk;
        }
      }
    }
  }
};
struct EpiS1 {
  float* S; int g, dir;
  __device__ __forceinline__ void operator()(int row0, int col0, f32x4 (&acc)[4][4], int lane) const {
    const int cl = lane & 15, rq = lane >> 4;
#pragma unroll
    for (int mi = 0; mi < 4; ++mi)
#pragma unroll
      for (int j = 0; j < 4; ++j) {
        const int cidx = row0 + mi * 16 + rq * 4 + j;
        if (cidx < 544) {
#pragma unroll
          for (int ni = 0; ni < 4; ++ni) S[(((size_t)cidx * 16 + g) * 2 + dir) * 128 + col0 + ni * 16 + cl] = acc[mi][ni][j];
        }
      }
  }
};
struct LoadS5A {
  const u16* U5; const u16* Hin; int g, m0;
  __device__ __forceinline__ const u16* operator()(int r, int k) const {
    int cidx = m0 + r; cidx = cidx < 544 ? cidx : 543;
    if (k < 1024) return U5 + (size_t)(chunk_row0(cidx) + (k >> 4)) * 256 + g * 16 + (k & 15);
    return Hin + ((size_t)cidx * 16 + g) * 256 + (k - 1024);
  }
};
__device__ __forceinline__ void phase3(KP kp, int layer, unsigned char* smem) {
  unsigned char* ws = kp->ws;
  const int tid = tidx();
  constexpr int MT = MTOT / 128;
  constexpr int N_Q = MT * 3, N_KV = MT * 4, N_S1 = 32 * 5;
  float* srs = (float*)(smem + 65536);
  for (int it = bidx(); it < N_Q + N_KV + N_S1; it += gridDim.x) {
    if (it < N_Q + N_KV) {
      const bool isq = it < N_Q;
      const int iq = isq ? it : it - N_Q;
      const int ntn = isq ? 3 : 4;
      const int mt = iq / ntn, nt = iq % ntn;
      const int KK = isq ? 192 : 128;
      const u16* A = isq ? (const u16*)(ws + OFF_CQ) : (const u16*)(ws + OFF_CKV);
      const u16* BT = isq ? ((const u16*)(ws + OFF_WUQT) + (size_t)layer * 384 * 192) : ((const u16*)(ws + OFF_WUKVT) + (size_t)layer * 512 * 128);
      __syncthreads();
      {
        const int r = tid >> 1, hf = tid & 1;
        const u16* rp = A + (size_t)(mt * 128 + r) * KK + hf * (KK / 2);
        float ss = 0.f;
        for (int i = 0; i < KK / 2; i += 8) {
          const u32x4 v = *(const u32x4*)(rp + i);
#pragma unroll
          for (int q = 0; q < 4; ++q) {
            const float lo = __uint_as_float(v[q] << 16), hi = __uint_as_float(v[q] & 0xffff0000u);
            ss += lo * lo + hi * hi;
          }
        }
        ss += __shfl_xor(ss, 1);
        if (hf == 0) srs[r] = rsqrtf(ss / (float)KK + EPSN);
      }
      LoadRows al{A + (size_t)mt * 128 * KK, KK}, bl{BT + (size_t)nt * 128 * KK, KK};
      if (isq) { EpiMlaQ epi{ws, srs, mt * 128}; gemm_dma(al, bl, KK, mt * 128, nt * 128, smem, epi); }
      else { EpiMlaKV epi{ws, srs, mt * 128}; gemm_dma(al, bl, KK, mt * 128, nt * 128, smem, epi); }
    } else {
      const int is = it - N_Q - N_KV;
      const int mt = is % 5, g = (is / 5) & 15, dir = is / 80;
      LoadS5A al{(const u16*)(ws + OFF_U5), (const u16*)(ws + OFF_HIN), g, mt * 128};
      LoadRows bl{(const u16*)(ws + OFF_W1) + ((size_t)((layer * 2 + dir) * 16 + g)) * 128 * 1024, 1024};
      EpiS1 epi{(float*)(ws + OFF_S5S), g, dir};
      gemm_dma(al, bl, 1024, mt * 128, 0, smem, epi);
    }
  }
}

template <int DK, int MODE>
__device__ __forceinline__ void attn_item(const u16* __restrict__ Qb, const u16* __restrict__ Kb, const u16* __restrict__ VTb, int qb,
                          u16* __restrict__ ymix, int ycol, int b, float sink_l2, const float* __restrict__ rpb_h, unsigned char* smem) {
  constexpr int KSTR = DK + 8;
  constexpr int VSTR = 68;
  constexpr int KCH = DK / 8;
  constexpr int NKL = (64 * KCH) / NT;
  constexpr int TILE_BYTES = 64 * KSTR * 2 + 64 * VSTR * 2;
  float* sBias = (float*)(smem + 2 * TILE_BYTES);
  const int tid = tidx(), lane = tid & 63, wave = tid >> 6;
  const int ql = lane & 31, hh = lane >> 5;
  const bool ctxq = qb >= 32;
  const int q0 = ctxq ? (4096 + (qb - 32) * 128) : qb * 128;
  const int myq = q0 + wave * 32 + ql;
  int seg0_start = 0, seg0_tiles = 0;
  if (!ctxq) {
    if (MODE == 0) { seg0_start = 0; seg0_tiles = 64; }
    else if (MODE == 1) { const int lo = (q0 - 128 < 0) ? 0 : q0 - 128; const int hi = (q0 + 256 > 4096) ? 4096 : q0 + 256; seg0_start = lo; seg0_tiles = (hi - lo) >> 6; }
    else { const int qr0 = q0 >> 6; int ra = qr0 - 4; ra = ra < 0 ? 0 : (ra > 56 ? 56 : ra); int rb = qr0 - 3; rb = rb < 0 ? 0 : (rb > 56 ? 56 : rb); seg0_start = ra * 64; seg0_tiles = rb + 8 - ra; }
  }
  const int ntiles = seg0_tiles + 4;
  __syncthreads();
  if (MODE == 2) {
    for (int i = tid; i < 15 * 31; i += NT) sBias[i] = rpb_h[i] * LOG2E;
  }
  bf16x8 qf[DK / 16];
#pragma unroll
  for (int st = 0; st < DK / 16; ++st) qf[st] = *(const bf16x8*)(Qb + (size_t)myq * DK + st * 16 + hh * 8);
  f32x16 o0, o1;
#pragma unroll
  for (int i = 0; i < 16; ++i) { o0[i] = 0.f; o1[i] = 0.f; }
  float mrow = 0.f, lsum = 0.f;
  const int qpos = myq;
  const int qrow = qpos >> 6, qcol = qpos & 63;
  int nr0 = qrow - 4; nr0 = nr0 < 0 ? 0 : (nr0 > 56 ? 56 : nr0);
  int ncs = qcol - 8; ncs = ncs < 0 ? 0 : (ncs > 48 ? 48 : ncs);

  u32x4 rk[NKL], rv[2];
  auto tile_start = [&](int t) { return (t < seg0_tiles) ? (seg0_start + t * 64) : (4096 + (t - seg0_tiles) * 64); };
  auto gload = [&](int t) {
    const int ks = tile_start(t);
#pragma unroll
    for (int i = 0; i < NKL; ++i) {
      const int id = tid + NT * i;
      const int row = id / KCH, c = id % KCH;
      rk[i] = *(const u32x4*)(Kb + (size_t)(ks + row) * DK + c * 8);
    }
#pragma unroll
    for (int i = 0; i < 2; ++i) {
      const int id = tid + NT * i;
      const int row = id >> 3, c = id & 7;
      rv[i] = *(const u32x4*)(VTb + (size_t)row * LK + ks + c * 8);
    }
  };
  auto lds_write = [&](int buf) {
    u16* wK = (u16*)(smem + buf * TILE_BYTES);
    u16* wV = (u16*)(smem + buf * TILE_BYTES + 64 * KSTR * 2);
#pragma unroll
    for (int i = 0; i < NKL; ++i) {
      const int id = tid + NT * i;
      const int row = id / KCH, c = id % KCH;
      *(u32x4*)(wK + row * KSTR + c * 8) = rk[i];
    }
#pragma unroll
    for (int i = 0; i < 2; ++i) {
      const int id = tid + NT * i;
      const int row = id >> 3, c = id & 7;
      u32x2 lo, hi; lo[0] = rv[i][0]; lo[1] = rv[i][1]; hi[0] = rv[i][2]; hi[1] = rv[i][3];
      *(u32x2*)(wV + row * VSTR + c * 8) = lo;
      *(u32x2*)(wV + row * VSTR + c * 8 + 4) = hi;
    }
  };
  auto qk_tile = [&](int buf, f32x16& a0, f32x16& a1) {
    const u16* sK = (const u16*)(smem + buf * TILE_BYTES);
    const float ini = -mrow;
#pragma unroll
    for (int i = 0; i < 16; ++i) { a0[i] = ini; a1[i] = ini; }
    bf16x8 kf0[DK / 16], kf1[DK / 16];
#pragma unroll
    for (int st = 0; st < DK / 16; ++st) {
      kf0[st] = *(const bf16x8*)(sK + ql * KSTR + st * 16 + hh * 8);
      kf1[st] = *(const bf16x8*)(sK + (32 + ql) * KSTR + st * 16 + hh * 8);
    }
    __builtin_amdgcn_sched_barrier(0);
    __builtin_amdgcn_s_setprio(1);
#pragma unroll
    for (int st = 0; st < DK / 16; ++st) {
      a0 = mfma32(kf0[st], qf[st], a0);
      a1 = mfma32(kf1[st], qf[st], a1);
    }
    __builtin_amdgcn_s_setprio(0);
  };
  gload(0);
  lds_write(0);
  if (ntiles > 1) gload(1);
  __syncthreads();
  f32x16 s0, s1;
  for (int t = 0; t < ntiles; ++t) {
    const int bcur = t & 1;
    if (t + 1 < ntiles) lds_write(bcur ^ 1);
    if (t + 2 < ntiles) gload(t + 2);
    qk_tile(bcur, s0, s1);
    const u16* sV = (const u16*)(smem + bcur * TILE_BYTES + 64 * KSTR * 2);
    const int kt0 = tile_start(t);
    if (MODE != 0 && !ctxq && t < seg0_tiles) {
      if (MODE == 1) {
        const int qw = q0 + wave * 32;
        const bool all_valid = (kt0 + 63 - qw <= 128) && (qw + 31 - kt0 <= 128);
        if (!all_valid) {
          const int base = qpos - kt0 - 4 * hh;
#pragma unroll
          for (int i = 0; i < 16; ++i) {
            const int d0 = base - ((i & 3) + 8 * (i >> 2)), d1 = d0 - 32;
            if (d0 > 128 || d0 < -128) s0[i] = -INFINITY;
            if (d1 > 128 || d1 < -128) s1[i] = -INFINITY;
          }
        }
      } else {
        const int kr = kt0 >> 6;
        const int dr = kr - nr0;
        const bool rowok = (dr >= 0) && (dr < 8);
        if (!rowok) {
#pragma unroll
          for (int i = 0; i < 16; ++i) { s0[i] = -INFINITY; s1[i] = -INFINITY; }
        } else {
          const float* bb = sBias + (kr - qrow + 7) * 31 + (15 - qcol + 4 * hh);
          const int eb = 4 * hh - ncs;
#pragma unroll
          for (int i = 0; i < 16; ++i) {
            const int ci = (i & 3) + 8 * (i >> 2);
            const float b0 = bb[ci], b1 = bb[ci + 32];
            s0[i] = ((unsigned)(eb + ci) < 16u) ? (s0[i] + b0) : -INFINITY;
            s1[i] = ((unsigned)(eb + ci + 32) < 16u) ? (s1[i] + b1) : -INFINITY;
          }
        }
      }
    }
    float mx = s0[0];
#pragma unroll
    for (int i = 1; i < 16; ++i) mx = fmaxf(mx, s0[i]);
#pragma unroll
    for (int i = 0; i < 16; ++i) mx = fmaxf(mx, s1[i]);
    mx = fmaxf(mx, __shfl_xor(mx, 32));
    const bool slow = (t == 0) || (__builtin_amdgcn_ballot_w64(mx > 8.0f) != 0ull);
    float ps = 0.f;
    if (slow) {
      const float dm = (t == 0) ? ((mx > -1e30f) ? mx : 0.f) : fmaxf(mx, 0.f);
      const float alpha = __builtin_amdgcn_exp2f(-dm);
      mrow += dm;
#pragma unroll
      for (int i = 0; i < 16; ++i) { s0[i] = __builtin_amdgcn_exp2f(s0[i] - dm); ps += s0[i]; }
#pragma unroll
      for (int i = 0; i < 16; ++i) { s1[i] = __builtin_amdgcn_exp2f(s1[i] - dm); ps += s1[i]; }
      lsum = lsum * alpha + ps;
#pragma unroll
      for (int i = 0; i < 16; ++i) { o0[i] *= alpha; o1[i] *= alpha; }
    } else {
#pragma unroll
      for (int i = 0; i < 16; ++i) { s0[i] = __builtin_amdgcn_exp2f(s0[i]); ps += s0[i]; }
#pragma unroll
      for (int i = 0; i < 16; ++i) { s1[i] = __builtin_amdgcn_exp2f(s1[i]); ps += s1[i]; }
      lsum += ps;
    }
    __builtin_amdgcn_s_setprio(1);
#pragma unroll
    for (int kb = 0; kb < 2; ++kb) {
#pragma unroll
      for (int sp = 0; sp < 2; ++sp) {
        union { bf16x8 v; unsigned u[4]; } pf;
#pragma unroll
        for (int q = 0; q < 4; ++q) {
          const float a = kb ? s1[8 * sp + 2 * q] : s0[8 * sp + 2 * q];
          const float c = kb ? s1[8 * sp + 2 * q + 1] : s0[8 * sp + 2 * q + 1];
          pf.u[q] = pack2(a, c);
        }
        const int koff = 32 * kb + 16 * sp + 4 * hh;
        union { bf16x8 v; u32x2 h[2]; } v0, v1;
        v0.h[0] = *(const u32x2*)(sV + ql * VSTR + koff);
        v0.h[1] = *(const u32x2*)(sV + ql * VSTR + koff + 8);
        v1.h[0] = *(const u32x2*)(sV + (32 + ql) * VSTR + koff);
        v1.h[1] = *(const u32x2*)(sV + (32 + ql) * VSTR + koff + 8);
        o0 = mfma32(v0.v, pf.v, o0);
        o1 = mfma32(v1.v, pf.v, o1);
      }
    }
    __builtin_amdgcn_s_setprio(0);
    __syncthreads();
  }
  float ltot = lsum + __shfl_xor(lsum, 32);
  if (MODE == 1) ltot += __builtin_amdgcn_exp2f(sink_l2 - mrow);
  const float inv = 1.0f / ltot;
  const int orow = ctxq ? (NLAT + b * 256 + (myq - 4096)) : (b * 4096 + myq);
  u16* dst = ymix + (size_t)orow * 1024 + ycol;
#pragma unroll
  for (int g4 = 0; g4 < 4; ++g4) {
    const int dv = 8 * g4 + 4 * hh;
    u32x2 pa, pb;
    pa[0] = pack2(o0[4 * g4] * inv, o0[4 * g4 + 1] * inv); pa[1] = pack2(o0[4 * g4 + 2] * inv, o0[4 * g4 + 3] * inv);
    pb[0] = pack2(o1[4 * g4] * inv, o1[4 * g4 + 1] * inv); pb[1] = pack2(o1[4 * g4 + 2] * inv, o1[4 * g4 + 3] * inv);
    *(u32x2*)(dst + dv) = pa;
    *(u32x2*)(dst + 32 + dv) = pb;
  }
}

__device__ __forceinline__ void phase4(KP kp, int layer, unsigned char* smem) {
  unsigned char* ws = kp->ws;
  const int n_lat = NB * 4 * 32;
  const int n_ctx = (layer == 0) ? NB * 4 * 2 : 0;
  const int n_carry = 64;
  const int total = 2 * n_lat + n_carry + 2 * n_ctx;
  u16* ymix = (u16*)(ws + OFF_H);
  for (int it = bidx(); it < total; it += gridDim.x) {
    int mixer, qb, head, b;
    bool carry = false;
    if (it < 2 * n_lat) {
      mixer = it / n_lat;
      const int ia = it % n_lat;
      const int x = ia & 7, li = ia >> 3;
      const int pid = x + 8 * (li >> 5);
      qb = li & 31; head = pid & 3; b = pid >> 2;
    }
    else if (it < 2 * n_lat + n_carry) { carry = true; mixer = 0; qb = 0; head = 0; b = 0; }
    else { const int ic = it - 2 * n_lat - n_carry; mixer = ic / n_ctx; const int ia = ic % n_ctx; qb = 32 + (ia & 1); head = (ia >> 1) & 3; b = ia >> 3; }
    if (carry) {
      const int e = (it - 2 * n_lat) * NT + tidx();
      const int pp = e & 63, dir = (e >> 6) & 1, g = (e >> 7) & 15, bb = e >> 11;
      const float2 a64 = ((const float2*)(ws + OFF_APOW))[(size_t)(((layer * 2 + dir) * 16 + g) * 64 + pp) * 65 + 64];
      const float* S = (const float*)(ws + OFF_S5S);
      u16* Hin = (u16*)(ws + OFF_HIN);
      float2 H = make_float2(0.f, 0.f);
#pragma unroll 1
      for (int i0 = 0; i0 < 68; i0 += 17) {
        float2 sv[17];
#pragma unroll
        for (int u = 0; u < 17; ++u) {
          const int i = i0 + u;
          const int c = (dir == 0) ? ((i < 4) ? (64 + i) : (i - 4)) : (67 - i);
          sv[u] = *(const float2*)(S + (((size_t)(bb * 68 + c) * 16 + g) * 2 + dir) * 128 + pp * 2);
        }
#pragma unroll
        for (int u = 0; u < 17; ++u) {
          const int i = i0 + u;
          const int c = (dir == 0) ? ((i < 4) ? (64 + i) : (i - 4)) : (67 - i);
          *(unsigned*)(Hin + ((size_t)(bb * 68 + c) * 16 + g) * 256 + dir * 128 + pp * 2) = pack2(H.x, H.y);
          const float2 ah = cmul(a64, H);
          H = make_float2(ah.x + sv[u].x, ah.y + sv[u].y);
        }
      }
    } else if (mixer == 0) {
      const int kvh = head >> 1;
      const u16* Qb = (const u16*)(ws + OFF_QA) + (size_t)(b * 4 + head) * LK * 64;
      const u16* Kb = (const u16*)(ws + OFF_KA) + (size_t)(b * 2 + kvh) * LK * 64;
      const u16* VTb = (const u16*)(ws + OFF_VTA) + (size_t)(b * 2 + kvh) * 64 * LK;
      const float sink = kp->in[I_SINK][layer * 4 + head] * LOG2E;
      attn_item<64, 1>(Qb, Kb, VTb, qb, ymix, head * 64, b, sink, nullptr, smem);
    } else {
      const u16* Qb = (const u16*)(ws + OFF_QD) + (size_t)(b * 4 + head) * LK * 64;
      const u16* Kb = (const u16*)(ws + OFF_KD) + (size_t)(b * 4 + head) * LK * 64;
      const u16* VTb = (const u16*)(ws + OFF_VTD) + (size_t)(b * 4 + head) * 64 * LK;
      attn_item<64, 2>(Qb, Kb, VTb, qb, ymix, 768 + head * 64, b, 0.f, kp->in[I_RPB] + (size_t)(layer * 4 + head) * 15 * 31, smem);
    }
  }
}

struct LoadS5B {
  const u16* tt; const u16* st; int g, n0;
  __device__ __forceinline__ const u16* operator()(int r, int k) const {
    const int n = n0 + r;
    if (k < 1024) return tt + (((size_t)g * 127 + ((n >> 4) - (k >> 4) + 63)) * 16 + (n & 15)) * 16 + (k & 15);
    return st + ((size_t)g * 1024 + n) * 256 + (k - 1024);
  }
};
struct EpiS3 {
  u16* YG; int g;
  __device__ __forceinline__ void operator()(int row0, int col0, f32x4 (&acc)[4][4], int lane) const {
    const int cl = lane & 15, rq = lane >> 4;
#pragma unroll
    for (int mi = 0; mi < 4; ++mi)
#pragma unroll
      for (int j = 0; j < 4; ++j) {
        const int cidx = row0 + mi * 16 + rq * 4 + j;
        if (cidx < 544) {
          const int r0 = chunk_row0(cidx);
#pragma unroll
          for (int ni = 0; ni < 4; ++ni) {
            const int jt = (col0 >> 4) + ni;
            YG[(size_t)(r0 + jt) * 256 + g * 16 + cl] = f2bf(gelu_tanh(acc[mi][ni][j]));
          }
        }
      }
  }
};
__device__ __forceinline__ void phase5(KP kp, int layer, unsigned char* smem, int sub = 0) {
  unsigned char* ws = kp->ws;
  const int n_lat = NB * 4 * 32;
  const int n_ctx = (layer == 0) ? NB * 4 * 2 : 0;
  const int n_att = n_lat + n_ctx;
  const int n_s3 = 16 * 5 * 8;
  u16* ymix = (u16*)(ws + OFF_H);
  for (int it = bidx(); it < n_att + n_s3; it += gridDim.x) {
    if (sub == 1 && it >= n_att) break;
    if (sub == 2 && it < n_att) continue;
    if (it < n_att) {
      int qb, head, b;
      if (it < n_lat) {
        const int x = it & 7, li = it >> 3;
        const int pid = x + 8 * (li >> 5);
        qb = li & 31; head = pid & 3; b = pid >> 2;
      } else { const int ia = it - n_lat; qb = 32 + (ia & 1); head = (ia >> 1) & 3; b = ia >> 3; }
      const u16* Qb = (const u16*)(ws + OFF_QB) + (size_t)(b * 4 + head) * LK * 96;
      const u16* Kb = (const u16*)(ws + OFF_KB) + (size_t)(b * 4 + head) * LK * 96;
      const u16* VTb = (const u16*)(ws + OFF_VTB) + (size_t)(b * 4 + head) * 64 * LK;
      attn_item<96, 0>(Qb, Kb, VTb, qb, ymix, 256 + head * 64, b, 0.f, nullptr, smem);
    } else {
      const int is = it - n_att;
      const int nt = is & 7, mt = (is >> 3) % 5, g = is / 40;
      LoadS5A al{(const u16*)(ws + OFF_U5), (const u16*)(ws + OFF_HIN), g, mt * 128};
      LoadS5B bl{(const u16*)(ws + OFF_TT), (const u16*)(ws + OFF_ST), g, nt * 128};
      EpiS3 epi{(u16*)(ws + OFF_YG), g};
      gemm_dma(al, bl, 1280, mt * 128, nt * 128, smem, epi);
    }
  }
}

struct EpiGlu {
  u16* ymix;
  __device__ __forceinline__ void operator()(int row0, int col0, f32x4 (&acc)[4][4], int lane) const {
    const int cl = lane & 15, rq = lane >> 4;
#pragma unroll
    for (int mi = 0; mi < 4; ++mi)
#pragma unroll
      for (int q = 0; q < 2; ++q)
#pragma unroll
        for (int j = 0; j < 4; ++j) {
          const int r = row0 + mi * 16 + rq * 4 + j;
          const float a = acc[mi][2 * q][j], gg = acc[mi][2 * q + 1][j];
          ymix[(size_t)r * 1024 + 512 + ((col0 >> 5) + q) * 16 + cl] = f2bf(a * sigmoidf_(gg));
        }
  }
};
__device__ __forceinline__ void phase6(KP kp, int layer, unsigned char* smem) {
  unsigned char* ws = kp->ws;
  const int mrows = (layer == 0) ? MTOT : NLAT;
  const int tid = tidx(), lane = tid & 63, wave = tid >> 6;
  u16* ymix = (u16*)(ws + OFF_H);
  EpiGlu epi{ymix};
  for (int mt = bidx(); mt < mrows / 128; mt += gridDim.x) {
    for (int nt = 0; nt < 4; ++nt) {
      LoadRows al{(const u16*)(ws + OFF_YG) + (size_t)mt * 128 * 256, 256};
      LoadRows bl{(const u16*)(ws + OFF_WGLUT) + (size_t)layer * 512 * 256 + (size_t)nt * 128 * 256, 256};
      gemm_dma(al, bl, 256, mt * 128, nt * 128, smem, epi);
    }
    asm volatile("s_waitcnt vmcnt(0)" ::: "memory");
    __syncthreads();
#pragma unroll 1
    for (int rb = 0; rb < 32; rb += 4) {
      u32x4 va[4], vb[4];
#pragma unroll
      for (int u = 0; u < 4; ++u) {
        const u32x4* ptr = (const u32x4*)(ymix + (size_t)(mt * 128 + wave * 32 + rb + u) * 1024 + lane * 16);
        va[u] = ptr[0]; vb[u] = ptr[1];
      }
#pragma unroll
      for (int u = 0; u < 4; ++u) {
        float f[16];
#pragma unroll
        for (int q = 0; q < 4; ++q) {
          f[2 * q] = __uint_as_float(va[u][q] << 16); f[2 * q + 1] = __uint_as_float(va[u][q] & 0xffff0000u);
          f[8 + 2 * q] = __uint_as_float(vb[u][q] << 16); f[8 + 2 * q + 1] = __uint_as_float(vb[u][q] & 0xffff0000u);
        }
        float ss = 0.f;
#pragma unroll
        for (int q = 0; q < 16; ++q) ss += f[q] * f[q];
#pragma unroll
        for (int o = 8; o >= 1; o >>= 1) ss += __shfl_xor(ss, o);
        const float rstd = rsqrtf(ss * (1.0f / 256.0f) + EPSN);
        u32x4 o0, o1;
#pragma unroll
        for (int q = 0; q < 4; ++q) {
          o0[q] = pack2(f[2 * q] * rstd, f[2 * q + 1] * rstd);
          o1[q] = pack2(f[8 + 2 * q] * rstd, f[8 + 2 * q + 1] * rstd);
        }
        u32x4* ptr = (u32x4*)((u16*)(ws + OFF_MIX) + ((size_t)(lane >> 1) * MTOT + (mt * 128 + wave * 32 + rb + u)) * 32 + (lane & 1) * 16);
        ptr[0] = o0; ptr[1] = o1;
      }
    }
  }
}

__device__ __forceinline__ void phase7(KP kp, int layer) {
  const int lane = tidx() & 63;
  const int gw = (bidx() * NT + tidx()) >> 6, nw = (gridDim.x * NT) >> 6;
  const int mrows = (layer == 0) ? MTOT : NLAT;
  u16* ymix = (u16*)(kp->ws + OFF_H);
  for (int r0 = gw; r0 < mrows; r0 += 4 * nw) {
    u32x4 va[4], vb[4];
#pragma unroll
    for (int u = 0; u < 4; ++u) {
      const int r = (r0 + u * nw < mrows) ? (r0 + u * nw) : r0;
      const u32x4* ptr = (const u32x4*)(ymix + (size_t)r * 1024 + lane * 16);
      va[u] = ptr[0]; vb[u] = ptr[1];
    }
#pragma unroll
    for (int u = 0; u < 4; ++u) {
      const int r = r0 + u * nw;
      if (r >= mrows) break;
      float f[16];
#pragma unroll
      for (int q = 0; q < 4; ++q) {
        f[2 * q] = __uint_as_float(va[u][q] << 16); f[2 * q + 1] = __uint_as_float(va[u][q] & 0xffff0000u);
        f[8 + 2 * q] = __uint_as_float(vb[u][q] << 16); f[8 + 2 * q + 1] = __uint_as_float(vb[u][q] & 0xffff0000u);
      }
      float ss = 0.f;
#pragma unroll
      for (int q = 0; q < 16; ++q) ss += f[q] * f[q];
#pragma unroll
      for (int o = 8; o >= 1; o >>= 1) ss += __shfl_xor(ss, o);
      const float rstd = rsqrtf(ss * (1.0f / 256.0f) + EPSN);
      u32x4 o0, o1;
#pragma unroll
      for (int q = 0; q < 4; ++q) {
        o0[q] = pack2(f[2 * q] * rstd, f[2 * q + 1] * rstd);
        o1[q] = pack2(f[8 + 2 * q] * rstd, f[8 + 2 * q + 1] * rstd);
      }
      u32x4* ptr = (u32x4*)(ymix + (size_t)r * 1024 + lane * 16);
      ptr[0] = o0; ptr[1] = o1;
    }
  }
}

struct EpiOut {
  const float* xlat; const float* xctx; float* olat; float* octx; const float* modl;
  __device__ __forceinline__ void operator()(int row0, int col0, f32x4 (&acc)[4][4], int lane) const {
    const int cl = lane & 15, rq = lane >> 4;
    const bool is_lat = row0 < NLAT;
    const int bb = is_lat ? (row0 >> 12) : 8;
#pragma unroll
    for (int mi = 0; mi < 4; ++mi) {
      const int r = row0 + mi * 16 + cl;
      const float* xin = is_lat ? (xlat + (size_t)r * 1024) : (xctx + (size_t)(r - NLAT) * 1024);
      float* xo = is_lat ? (olat + (size_t)r * 1024) : (octx + (size_t)(r - NLAT) * 1024);
#pragma unroll
      for (int ni = 0; ni < 4; ++ni) {
        const int col = col0 + ni * 16 + rq * 4;
        const f32x4 g1 = *(const f32x4*)(modl + (size_t)bb * 6144 + 2048 + col);
        const f32x4 xi = *(const f32x4*)(xin + col);
        f32x4 o;
#pragma unroll
        for (int j = 0; j < 4; ++j) o[j] = xi[j] + g1[j] * acc[mi][ni][j];
        *(f32x4*)(xo + col) = o;
      }
    }
  }
};
__device__ __forceinline__ void phase8(KP kp, int layer, unsigned char* smem) {
  unsigned char* ws = kp->ws;
  EpiOut epi;
  epi.xlat = (layer == 0) ? kp->in[I_X] : kp->out;
  epi.xctx = kp->in[I_CTX];
  epi.olat = kp->out;
  epi.octx = (float*)(ws + OFF_XC);
  epi.modl = (const float*)(ws + OFF_MOD) + (size_t)layer * 9 * 6144;
  const u16* A = (const u16*)(ws + OFF_MIX);
  const u16* BT = (const u16*)(ws + OFF_WOUTT) + (size_t)layer * 1024 * 1024;
  const int bid = bidx(), nblk = gridDim.x;
  for (int r = 0;; ++r) {
    int mt, nt;
    if (!xcd_tile(bid, nblk, r, NLAT / 256, 8, mt, nt)) break;
    LoadKB al{A + (size_t)mt * 256 * 32, MTOT}, bl{BT + (size_t)nt * 128 * 32, 1024};
    gemm_dma3<true>(al, bl, 1024, mt * 256, nt * 128, smem, epi);
  }
  if (layer == 0) {
    for (int it = bid; it < 16 * 8; it += nblk) {
      const int mt = NLAT / 128 + (it >> 3), nt = it & 7;
      LoadKB al{A + (size_t)mt * 128 * 32, MTOT}, bl{BT + (size_t)nt * 128 * 32, 1024};
      gemm_dma<true>(al, bl, 1024, mt * 128, nt * 128, smem, epi);
    }
  }
}

__device__ __forceinline__ void phase9(KP kp, int layer) {
  const int mrows = (layer == 0) ? MTOT : NLAT;
  norm_mod_rows<true>(kp->out, (const float*)(kp->ws + OFF_XC), kp->in[I_N2G] + layer * 1024, (const float*)(kp->ws + OFF_MOD) + (size_t)layer * 9 * 6144,
                3072, 4096, (u16*)(kp->ws + OFF_H), mrows);
}

struct EpiQ {
  u16* q;
  __device__ __forceinline__ void operator()(int row0, int col0, f32x4 (&acc)[4][4], int lane) const {
    const int cl = lane & 15, rq = lane >> 4;
#pragma unroll
    for (int mi = 0; mi < 4; ++mi)
#pragma unroll
      for (int ni = 0; ni < 4; ++ni) {
        u32x2 pk; pk[0] = pack2(acc[mi][ni][0], acc[mi][ni][1]); pk[1] = pack2(acc[mi][ni][2], acc[mi][ni][3]);
        *(u32x2*)(q + (size_t)(row0 + mi * 16 + cl) * 2048 + col0 + ni * 16 + rq * 4) = pk;
      }
  }
};
__device__ __forceinline__ void phase10(KP kp, int layer, unsigned char* smem) {
  unsigned char* ws = kp->ws;
  EpiQ epi{(u16*)(ws + OFF_QPEER)};
  const u16* A = (const u16*)(ws + OFF_H);
  const u16* BT = (const u16*)(ws + OFF_WQT) + (size_t)layer * 2048 * 1024;
  const int bid = bidx(), nblk = gridDim.x;
  for (int r = 0;; ++r) {
    int mt, nt;
    if (!xcd_tile(bid, nblk, r, NLAT / 256, 16, mt, nt)) break;
    LoadKB al{A + (size_t)mt * 256 * 32, MTOT}, bl{BT + (size_t)nt * 128 * 32, 2048};
    gemm_dma3<true>(al, bl, 1024, mt * 256, nt * 128, smem, epi);
  }
  if (layer == 0) {
    for (int it = bid; it < 16 * 16; it += nblk) {
      const int mt = NLAT / 128 + (it >> 4), nt = it & 15;
      LoadKB al{A + (size_t)mt * 128 * 32, MTOT}, bl{BT + (size_t)nt * 128 * 32, 2048};
      gemm_dma<true>(al, bl, 1024, mt * 128, nt * 128, smem, epi);
    }
  }
}

#define CE_DESC(x, y) { const float hi_ = fmaxf(x, y); const float lo_ = fminf(x, y); x = hi_; y = lo_; }
template <int N>
__device__ __forceinline__ void bitonic_sort_desc(float (&a)[N]) {
#pragma unroll
  for (int k = 2; k <= N; k <<= 1)
#pragma unroll
    for (int jj = k >> 1; jj > 0; jj >>= 1)
#pragma unroll
      for (int i = 0; i < N; ++i) {
        const int l = i ^ jj;
        if (l > i) {
          if ((i & k) == 0) CE_DESC(a[i], a[l]) else CE_DESC(a[l], a[i])
        }
      }
}
__device__ __forceinline__ void bitonic_merge16_desc(float (&a)[16]) {
#pragma unroll
  for (int jj = 8; jj > 0; jj >>= 1)
#pragma unroll
    for (int i = 0; i < 16; ++i) {
      const int l = i ^ jj;
      if (l > i) CE_DESC(a[i], a[l])
    }
}
__device__ __forceinline__ void merge_top16(float (&a)[16], const float (&b)[16]) {
#pragma unroll
  for (int i = 0; i < 16; ++i) a[i] = fmaxf(a[i], b[15 - i]);
  bitonic_merge16_desc(a);
}
__device__ __forceinline__ void merge_top16_xlane(float (&a)[16], int xmask) {
  float o[16];
#pragma unroll
  for (int i = 0; i < 16; ++i) o[i] = __shfl_xor(a[15 - i], xmask);
#pragma unroll
  for (int i = 0; i < 16; ++i) a[i] = fmaxf(a[i], o[i]);
  bitonic_merge16_desc(a);
}
__device__ __forceinline__ float packc(float v, unsigned code) { return __uint_as_float((__float_as_uint(v) & ~255u) | code); }
__device__ __forceinline__ void phase11(KP kp, int layer, unsigned char* smem) {
  unsigned char* ws = kp->ws;
  const int tid = tidx(), lane = tid & 63, wave = tid >> 6, ql = lane & 31, hh = lane >> 5;
  const int mrows = (layer == 0) ? MTOT : NLAT;
  const u16* Q = (const u16*)(ws + OFF_QPEER);
  const u16* SK = (const u16*)(ws + OFF_SUBK) + (size_t)layer * 2 * 128 * 128;
  u16* IDX = (u16*)(ws + OFF_IDX);
  float* GATE = (float*)(ws + OFF_GATE);
  unsigned* sL = (unsigned*)(smem + 65536);
  u16* sSK = (u16*)smem;
  const int jh = wave & 1, pb = wave >> 1;
  const int pr = pb * 32 + ql;
  __syncthreads();
#pragma unroll
  for (int i = 0; i < 16; ++i) {
    const int id = tid + NT * i;
    const int row = id >> 4, c = id & 15;
    *(u32x4*)(sSK + row * 128 + ((c ^ (row & 15)) * 8)) = *(const u32x4*)(SK + (size_t)row * 128 + c * 8);
  }
  __syncthreads();
  for (int it = bidx(); it < mrows / 8; it += gridDim.x) {
    const int tok0 = it * 8;
    const u16* qrow = Q + (size_t)(tok0 + (pr >> 3)) * 2048 + (pr & 7) * 256 + jh * 128 + hh * 8;
    bf16x8 qf[8];
#pragma unroll
    for (int st = 0; st < 8; ++st) qf[st] = *(const bf16x8*)(qrow + st * 16);
    float top[16];
#pragma unroll
    for (int kt = 0; kt < 4; ++kt) {
      f32x16 acc;
#pragma unroll
      for (int i = 0; i < 16; ++i) acc[i] = 0.f;
#pragma unroll
      for (int st = 0; st < 8; ++st) {
        const int krow = jh * 128 + kt * 32 + ql;
        const bf16x8 kf = *(const bf16x8*)(sSK + krow * 128 + (((st * 2 + hh) ^ (krow & 15)) * 8));
        acc = mfma32(kf, qf[st], acc);
      }
      float v[16];
#pragma unroll
      for (int i = 0; i < 16; ++i)
        v[i] = __uint_as_float((__float_as_uint(acc[i]) & ~127u) | (unsigned)(32 * kt + (i & 3) + 8 * (i >> 2)) | (unsigned)(hh << 2));
      bitonic_sort_desc<16>(v);
      if (kt == 0) {
#pragma unroll
        for (int i = 0; i < 16; ++i) top[i] = v[i];
      } else merge_top16(top, v);
    }
    merge_top16_xlane(top, 32);
    __syncthreads();
    if (hh == 0) {
#pragma unroll
      for (int q = 0; q < 4; ++q) {
        u32x4 w;
        w[0] = __float_as_uint(top[4 * q]); w[1] = __float_as_uint(top[4 * q + 1]); w[2] = __float_as_uint(top[4 * q + 2]); w[3] = __float_as_uint(top[4 * q + 3]);
        *(u32x4*)(sL + (jh * 64 + pr) * 16 + 4 * q) = w;
      }
    }
    __syncthreads();
    const int pair = tid >> 2, sub = tid & 3;
    const unsigned* l1 = sL + pair * 16;
    const unsigned* l2 = sL + (64 + pair) * 16;
    float v2[16];
#pragma unroll
    for (int q = 0; q < 4; ++q) {
      const u32x4 w = *(const u32x4*)(l2 + 4 * q);
      v2[4 * q] = __uint_as_float(w[0] & ~127u); v2[4 * q + 1] = __uint_as_float(w[1] & ~127u);
      v2[4 * q + 2] = __uint_as_float(w[2] & ~127u); v2[4 * q + 3] = __uint_as_float(w[3] & ~127u);
    }
    const float va0 = __uint_as_float(l1[sub] & ~127u), va1 = __uint_as_float(l1[4 + sub] & ~127u);
    const float va2 = __uint_as_float(l1[8 + sub] & ~127u), va3 = __uint_as_float(l1[12 + sub] & ~127u);
    const unsigned sc = (unsigned)sub << 4;
    float c[16], X[8];
#pragma unroll
    for (int b = 0; b < 16; ++b) c[b] = packc(va0 + v2[b], sc | (unsigned)b);
#pragma unroll
    for (int b = 0; b < 4; ++b) X[b] = packc(va1 + v2[b], sc | (unsigned)(64 + b));
    X[4] = packc(va2 + v2[0], sc | 128u); X[5] = packc(va2 + v2[1], sc | 129u);
    X[6] = packc(va3 + v2[0], sc | 192u); X[7] = -3.0e38f;
    bitonic_sort_desc<8>(X);
#pragma unroll
    for (int i = 8; i < 16; ++i) c[i] = fmaxf(c[i], X[15 - i]);
    bitonic_merge16_desc(c);
    merge_top16_xlane(c, 1);
    merge_top16_xlane(c, 2);
    const float mx = __uint_as_float(__float_as_uint(c[0]) & ~255u);
    float w[16]; int ex[16]; float sum = 0.f;
#pragma unroll
    for (int i = 0; i < 16; ++i) {
      const unsigned bits = __float_as_uint(c[i]);
      const int code = bits & 255, a = code >> 4, b = code & 15;
      ex[i] = (int)(l1[a] & 127u) * 128 + (int)(l2[b] & 127u);
      w[i] = __expf(__uint_as_float(bits & ~255u) - mx);
      sum += w[i];
    }
    const float inv = 1.0f / sum;
    const size_t o = ((size_t)tok0 * 8 + pair) * 16;
#pragma unroll
    for (int i = 0; i < 16; ++i)
      if ((i & 3) == sub) { IDX[o + i] = (u16)ex[i]; GATE[o + i] = w[i] * inv; }
  }
}

typedef __attribute__((ext_vector_type(2))) float f32x2;
typedef __attribute__((ext_vector_type(2))) _Float16 h16x2;
__device__ __forceinline__ int idx_of(const u32x4& lo, const u32x4& hi, int k) {
  const unsigned w = (k < 8) ? lo[(k & 7) >> 1] : hi[(k & 7) >> 1];
  return (k & 1) ? (int)(w >> 16) : (int)(w & 0xffffu);
}
__device__ __forceinline__ float dot32_fp4(const u32x4& v, const h16x2 (&t2)[16]) {
  float a = 0.f;
#pragma unroll
  for (int q = 0; q < 4; ++q) {
    a = __builtin_amdgcn_fdot2(__builtin_amdgcn_cvt_scalef32_pk_f16_fp4(v[q], 1.0f, 0), t2[4 * q], a, false);
    a = __builtin_amdgcn_fdot2(__builtin_amdgcn_cvt_scalef32_pk_f16_fp4(v[q], 1.0f, 1), t2[4 * q + 1], a, false);
    a = __builtin_amdgcn_fdot2(__builtin_amdgcn_cvt_scalef32_pk_f16_fp4(v[q], 1.0f, 2), t2[4 * q + 2], a, false);
    a = __builtin_amdgcn_fdot2(__builtin_amdgcn_cvt_scalef32_pk_f16_fp4(v[q], 1.0f, 3), t2[4 * q + 3], a, false);
  }
  return a;
}
__device__ __forceinline__ void phase12a(KP kp, int layer) {
  unsigned char* ws = kp->ws;
  const int tid = tidx(), lane = tid & 63, wave = tid >> 6, m = lane & 7, j = lane >> 3;
  const int bid = bidx();
  const int c = bid & 3;
  const int wsl = (bid >> 2) * 4 + wave, nwsl = (gridDim.x >> 2) * 4;
  const int mrows = (layer == 0) ? MTOT : NLAT;
  const u16* H = (const u16*)(ws + OFF_H) + (size_t)(c * 8 + m) * MTOT * 32;
  const unsigned char* U4 = (const unsigned char*)(ws + OFF_UB) + c * 128 + m * 16;
  const u16* IDX = (const u16*)(ws + OFF_IDX) + 16 * j;
  u16* PART = (u16*)(ws + OFF_QPEER) + (size_t)c * MTOT * 128;
  int n = wsl;
  if (n >= mrows) return;
  u32x4 ic_lo = *(const u32x4*)(IDX + (size_t)n * 128), ic_hi = *(const u32x4*)(IDX + (size_t)n * 128 + 8);
  u32x4 in_lo = ic_lo, in_hi = ic_hi;
  if (n + nwsl < mrows) { in_lo = *(const u32x4*)(IDX + (size_t)(n + nwsl) * 128); in_hi = *(const u32x4*)(IDX + (size_t)(n + nwsl) * 128 + 8); }
  u32x4 va[8], vb[8];
#pragma unroll
  for (int k = 0; k < 8; ++k) va[k] = *(const u32x4*)(U4 + (size_t)idx_of(ic_lo, ic_hi, k) * 512);
  u32x4 t4[4];
#pragma unroll
  for (int i = 0; i < 4; ++i) t4[i] = *(const u32x4*)(H + (size_t)n * 32 + 8 * i);
  for (; n < mrows; n += nwsl) {
    const bool has1 = (n + nwsl < mrows), has2 = (n + 2 * nwsl < mrows);
    u32x4 i2_lo = in_lo, i2_hi = in_hi;
    if (has2) { i2_lo = *(const u32x4*)(IDX + (size_t)(n + 2 * nwsl) * 128); i2_hi = *(const u32x4*)(IDX + (size_t)(n + 2 * nwsl) * 128 + 8); }
#pragma unroll
    for (int k = 0; k < 8; ++k) vb[k] = *(const u32x4*)(U4 + (size_t)idx_of(ic_lo, ic_hi, 8 + k) * 512);
    h16x2 t2[16];
#pragma unroll
    for (int i = 0; i < 4; ++i)
#pragma unroll
      for (int q = 0; q < 4; ++q)
        t2[4 * i + q] = __builtin_bit_cast(h16x2, __builtin_amdgcn_cvt_pkrtz(__uint_as_float(t4[i][q] << 16), __uint_as_float(t4[i][q] & 0xffff0000u)));
    float p[16];
#pragma unroll
    for (int k = 0; k < 8; ++k) p[k] = dot32_fp4(va[k], t2);
    if (has1) {
#pragma unroll
      for (int k = 0; k < 8; ++k) va[k] = *(const u32x4*)(U4 + (size_t)idx_of(in_lo, in_hi, k) * 512);
#pragma unroll
      for (int i = 0; i < 4; ++i) t4[i] = *(const u32x4*)(H + (size_t)(n + nwsl) * 32 + 8 * i);
    }
#pragma unroll
    for (int k = 0; k < 8; ++k) p[8 + k] = dot32_fp4(vb[k], t2);
    float q8[8], q4[4], q2[2];
#pragma unroll
    for (int i = 0; i < 8; ++i) { const float keep = (lane & 4) ? p[i + 8] : p[i]; const float send = (lane & 4) ? p[i] : p[i + 8]; q8[i] = keep + __shfl_xor(send, 4); }
#pragma unroll
    for (int i = 0; i < 4; ++i) { const float keep = (lane & 2) ? q8[i + 4] : q8[i]; const float send = (lane & 2) ? q8[i] : q8[i + 4]; q4[i] = keep + __shfl_xor(send, 2); }
#pragma unroll
    for (int i = 0; i < 2; ++i) { const float keep = (lane & 1) ? q4[i + 2] : q4[i]; const float send = (lane & 1) ? q4[i] : q4[i + 2]; q2[i] = keep + __shfl_xor(send, 1); }
    const int kb = ((lane & 4) ? 8 : 0) + ((lane & 2) ? 4 : 0) + ((lane & 1) ? 2 : 0);
    *(unsigned*)(PART + (size_t)n * 128 + 16 * j + kb) = pack2(q2[0], q2[1]);
    ic_lo = in_lo; ic_hi = in_hi; in_lo = i2_lo; in_hi = i2_hi;
  }
}
__device__ __forceinline__ void phase12b(KP kp, int layer) {
  unsigned char* ws = kp->ws;
  const int gtid = bidx() * NT + tidx(), gn = gridDim.x * NT;
  const int mrows = (layer == 0) ? MTOT : NLAT;
  const u32x2* PART = (const u32x2*)(ws + OFF_QPEER);
  const f32x4* GATE = (const f32x4*)(ws + OFF_GATE);
  u32x2* W = (u32x2*)(ws + OFF_YG);
  for (int e = gtid; e < mrows * 32; e += gn) {
    f32x4 p[4];
#pragma unroll
    for (int c = 0; c < 4; ++c) {
      const u32x2 v = PART[(size_t)c * MTOT * 32 + e];
      p[c][0] = __uint_as_float(v[0] << 16); p[c][1] = __uint_as_float(v[0] & 0xffff0000u);
      p[c][2] = __uint_as_float(v[1] << 16); p[c][3] = __uint_as_float(v[1] & 0xffff0000u);
    }
    const f32x4 g = GATE[e];
    f32x4 o;
#pragma unroll
    for (int j = 0; j < 4; ++j) {
      const float s = (p[0][j] + p[1][j]) + (p[2][j] + p[3][j]);
      o[j] = g[j] * gelu_tanh(s * (1.0f / 64.0f));
    }
    u32x2 pk; pk[0] = pack2(o[0], o[1]); pk[1] = pack2(o[2], o[3]);
    W[e] = pk;
  }
}
__device__ __forceinline__ void fma32_fp4(const u32x4& v, const h16x2 w2, h16x2 (&hacc)[16]) {
#pragma unroll
  for (int q = 0; q < 4; ++q) {
    hacc[4 * q] = __builtin_amdgcn_cvt_scalef32_pk_f16_fp4(v[q], 1.0f, 0) * w2 + hacc[4 * q];
    hacc[4 * q + 1] = __builtin_amdgcn_cvt_scalef32_pk_f16_fp4(v[q], 1.0f, 1) * w2 + hacc[4 * q + 1];
    hacc[4 * q + 2] = __builtin_amdgcn_cvt_scalef32_pk_f16_fp4(v[q], 1.0f, 2) * w2 + hacc[4 * q + 2];
    hacc[4 * q + 3] = __builtin_amdgcn_cvt_scalef32_pk_f16_fp4(v[q], 1.0f, 3) * w2 + hacc[4 * q + 3];
  }
}
__device__ __forceinline__ void phase12c(KP kp, int layer) {
  unsigned char* ws = kp->ws;
  const int tid = tidx(), lane = tid & 63, wave = tid >> 6, m = lane & 7, j = lane >> 3;
  const int bid = bidx();
  const int c = bid & 3;
  const int wsl = (bid >> 2) * 4 + wave, nwsl = (gridDim.x >> 2) * 4;
  const int mrows = (layer == 0) ? MTOT : NLAT;
  const unsigned char* V4 = (const unsigned char*)(ws + OFF_VB) + c * 128 + m * 16;
  const u16* IDX = (const u16*)(ws + OFF_IDX) + 16 * j;
  const u16* W = (const u16*)(ws + OFF_YG) + 16 * j;
  const float* modl = (const float*)(ws + OFF_MOD) + (size_t)layer * 9 * 6144;
  int n = wsl;
  if (n >= mrows) return;
  u32x4 ic_lo = *(const u32x4*)(IDX + (size_t)n * 128), ic_hi = *(const u32x4*)(IDX + (size_t)n * 128 + 8);
  u32x4 in_lo = ic_lo, in_hi = ic_hi;
  if (n + nwsl < mrows) { in_lo = *(const u32x4*)(IDX + (size_t)(n + nwsl) * 128); in_hi = *(const u32x4*)(IDX + (size_t)(n + nwsl) * 128 + 8); }
  u32x4 va[8], vb[8];
#pragma unroll
  for (int k = 0; k < 8; ++k) va[k] = *(const u32x4*)(V4 + (size_t)idx_of(ic_lo, ic_hi, k) * 512);
  u32x4 wq[2];
  wq[0] = *(const u32x4*)(W + (size_t)n * 128); wq[1] = *(const u32x4*)(W + (size_t)n * 128 + 8);
  const int qb = ((lane & 32) ? 16 : 0) + ((lane & 16) ? 8 : 0) + ((lane & 8) ? 4 : 0);
  const int col = c * 256 + 32 * m + qb;
  for (; n < mrows; n += nwsl) {
    const bool has1 = (n + nwsl < mrows), has2 = (n + 2 * nwsl < mrows);
    u32x4 i2_lo = in_lo, i2_hi = in_hi;
    if (has2) { i2_lo = *(const u32x4*)(IDX + (size_t)(n + 2 * nwsl) * 128); i2_hi = *(const u32x4*)(IDX + (size_t)(n + 2 * nwsl) * 128 + 8); }
#pragma unroll
    for (int k = 0; k < 8; ++k) vb[k] = *(const u32x4*)(V4 + (size_t)idx_of(ic_lo, ic_hi, 8 + k) * 512);
    const bool is_lat = n < NLAT;
    const int bb = is_lat ? (n >> 12) : 8;
    float* xr = is_lat ? (kp->out + (size_t)n * 1024) : ((float*)(ws + OFF_XC) + (size_t)(n - NLAT) * 1024);
    const f32x4 x1 = *(const f32x4*)(xr + col);
    const f32x4 g2 = *(const f32x4*)(modl + (size_t)bb * 6144 + 5120 + col);
    h16x2 hacc[16];
#pragma unroll
    for (int q = 0; q < 16; ++q) hacc[q] = (h16x2){(_Float16)0.f, (_Float16)0.f};
#pragma unroll
    for (int k = 0; k < 8; ++k) {
      const unsigned wb = wq[0][k >> 1];
      const float wv = (k & 1) ? __uint_as_float(wb & 0xffff0000u) : __uint_as_float(wb << 16);
      const h16x2 w2 = __builtin_bit_cast(h16x2, __builtin_amdgcn_cvt_pkrtz(wv, wv));
      fma32_fp4(va[k], w2, hacc);
    }
    u32x4 wn[2];
    wn[0] = wq[0]; wn[1] = wq[1];
    if (has1) {
#pragma unroll
      for (int k = 0; k < 8; ++k) va[k] = *(const u32x4*)(V4 + (size_t)idx_of(in_lo, in_hi, k) * 512);
      wn[0] = *(const u32x4*)(W + (size_t)(n + nwsl) * 128); wn[1] = *(const u32x4*)(W + (size_t)(n + nwsl) * 128 + 8);
    }
#pragma unroll
    for (int k = 0; k < 8; ++k) {
      const unsigned wb = wq[1][k >> 1];
      const float wv = (k & 1) ? __uint_as_float(wb & 0xffff0000u) : __uint_as_float(wb << 16);
      const h16x2 w2 = __builtin_bit_cast(h16x2, __builtin_amdgcn_cvt_pkrtz(wv, wv));
      fma32_fp4(vb[k], w2, hacc);
    }
    f32x2 acc[16];
#pragma unroll
    for (int q = 0; q < 16; ++q) { acc[q][0] = (float)hacc[q][0]; acc[q][1] = (float)hacc[q][1]; }
    f32x2 q8[8], q4[4], q2[2];
#pragma unroll
    for (int i = 0; i < 8; ++i) {
      const f32x2 keep = (lane & 32) ? acc[i + 8] : acc[i];
      const f32x2 send = (lane & 32) ? acc[i] : acc[i + 8];
      q8[i][0] = keep[0] + __shfl_xor(send[0], 32); q8[i][1] = keep[1] + __shfl_xor(send[1], 32);
    }
#pragma unroll
    for (int i = 0; i < 4; ++i) {
      const f32x2 keep = (lane & 16) ? q8[i + 4] : q8[i];
      const f32x2 send = (lane & 16) ? q8[i] : q8[i + 4];
      q4[i][0] = keep[0] + __shfl_xor(send[0], 16); q4[i][1] = keep[1] + __shfl_xor(send[1], 16);
    }
#pragma unroll
    for (int i = 0; i < 2; ++i) {
      const f32x2 keep = (lane & 8) ? q4[i + 2] : q4[i];
      const f32x2 send = (lane & 8) ? q4[i] : q4[i + 2];
      q2[i][0] = keep[0] + __shfl_xor(send[0], 8); q2[i][1] = keep[1] + __shfl_xor(send[1], 8);
    }
    f32x4 o;
    o[0] = x1[0] + g2[0] * (0.5f * q2[0][0]); o[1] = x1[1] + g2[1] * (0.5f * q2[0][1]);
    o[2] = x1[2] + g2[2] * (0.5f * q2[1][0]); o[3] = x1[3] + g2[3] * (0.5f * q2[1][1]);
    *(f32x4*)(xr + col) = o;
    wq[0] = wn[0]; wq[1] = wn[1];
    ic_lo = in_lo; ic_hi = in_hi; in_lo = i2_lo; in_hi = i2_hi;
  }
}
__device__ __forceinline__ void phase13(KP kp) {
  const int lane = tidx() & 63;
  const int gw = (bidx() * NT + tidx()) >> 6, nw = (gridDim.x * NT) >> 6;
  const float* fg = kp->in[I_FNG];
  for (int r0 = gw; r0 < NLAT; r0 += 2 * nw) {
    f32x4 v[2][4];
#pragma unroll
    for (int u = 0; u < 2; ++u) {
      const int r = (r0 + u * nw < NLAT) ? (r0 + u * nw) : r0;
      const float* row = kp->out + (size_t)r * 1024;
#pragma unroll
      for (int i = 0; i < 4; ++i) v[u][i] = *(const f32x4*)(row + i * 256 + lane * 4);
    }
#pragma unroll
    for (int u = 0; u < 2; ++u) {
      const int r = r0 + u * nw;
      if (r >= NLAT) break;
      float* row = kp->out + (size_t)r * 1024;
      float ss = 0.f;
#pragma unroll
      for (int i = 0; i < 4; ++i) ss += v[u][i][0] * v[u][i][0] + v[u][i][1] * v[u][i][1] + v[u][i][2] * v[u][i][2] + v[u][i][3] * v[u][i][3];
      ss = wave_sum(ss);
      const float rstd = rsqrtf(ss * (1.0f / 1024.0f) + EPSN);
#pragma unroll
      for (int i = 0; i < 4; ++i) {
        const f32x4 g = *(const f32x4*)(fg + i * 256 + lane * 4);
        f32x4 o; o[0] = v[u][i][0] * rstd * g[0]; o[1] = v[u][i][1] * rstd * g[1]; o[2] = v[u][i][2] * rstd * g[2]; o[3] = v[u][i][3] * rstd * g[3];
        *(f32x4*)(row + i * 256 + lane * 4) = o;
      }
    }
  }
}

#if PEER_OLD
__device__ __forceinline__ float dot8(u32x4 a, u32x4 b, float acc) {
  asm volatile("v_dot2c_f32_bf16 %0, %1, %5\n\tv_dot2c_f32_bf16 %0, %2, %6\n\tv_dot2c_f32_bf16 %0, %3, %7\n\tv_dot2c_f32_bf16 %0, %4, %8\n\ts_nop 3"
               : "+v"(acc) : "v"(a.x), "v"(a.y), "v"(a.z), "v"(a.w), "v"(b.x), "v"(b.y), "v"(b.z), "v"(b.w));
  return acc;
}
__device__ __forceinline__ void phase12(KP kp, int layer, bool dry = false) {
  unsigned char* ws = kp->ws;
  const int lane = tidx() & 63;
  const int gw = (bidx() * NT + tidx()) >> 6, nw = (gridDim.x * NT) >> 6;
  const int mrows = (layer == 0) ? MTOT : NLAT;
  const bool last = (layer == 1);
  const u16* H = (const u16*)(ws + OFF_H);
  const u16* UB = (const u16*)(ws + OFF_UB);
  const u16* VB = (const u16*)(ws + OFF_VB);
  const int* IDX = (const int*)(ws + OFF_IDX);
  const float* GATE = (const float*)(ws + OFF_GATE);
  const float* modl = (const float*)(ws + OFF_MOD) + (size_t)layer * 9 * 6144;
  for (int tok = gw; tok < mrows; tok += nw) {
    const u32x4 t0 = *(const u32x4*)(H + (size_t)tok * 1024 + lane * 8);
    const u32x4 t1 = *(const u32x4*)(H + (size_t)tok * 1024 + 512 + lane * 8);
    const int ia = IDX[(size_t)tok * 128 + lane], ib = IDX[(size_t)tok * 128 + 64 + lane];
    const float ga = GATE[(size_t)tok * 128 + lane], gb = GATE[(size_t)tok * 128 + 64 + lane];
#if PEER_SIMPLE
    float acc[16];
#pragma unroll
    for (int i = 0; i < 16; ++i) acc[i] = 0.f;
#pragma unroll 1
    for (int s = 0; s < 128; ++s) {
      const int e = __builtin_amdgcn_readlane((s < 64) ? ia : ib, s & 63);
      const float gt = __uint_as_float(__builtin_amdgcn_readlane(__float_as_uint((s < 64) ? ga : gb), s & 63));
      const u16* ur = UB + (size_t)e * 1024;
      const u32x4 ua = *(const u32x4*)(ur + lane * 8);
      const u32x4 ub = *(const u32x4*)(ur + 512 + lane * 8);
      float d = dot8(ub, t1, dot8(ua, t0, 0.f));
      d = wave_sum(d);
      const float wgt = gt * gelu_tanh(d);
      const u16* vr = VB + (size_t)e * 1024;
      const u32x4 a = *(const u32x4*)(vr + lane * 8);
      const u32x4 b = *(const u32x4*)(vr + 512 + lane * 8);
#pragma unroll
      for (int q = 0; q < 4; ++q) {
        acc[2 * q] += wgt * __uint_as_float(a[q] << 16);
        acc[2 * q + 1] += wgt * __uint_as_float(a[q] & 0xffff0000u);
        acc[8 + 2 * q] += wgt * __uint_as_float(b[q] << 16);
        acc[8 + 2 * q + 1] += wgt * __uint_as_float(b[q] & 0xffff0000u);
      }
    }
#else
    float wlo = 0.f, whi = 0.f;
#pragma unroll 1
    for (int bt = 0; bt < 16; ++bt) {
      const int iv = (bt < 8) ? ia : ib;
      const float gv = (bt < 8) ? ga : gb;
      const int sb = (bt & 7) * 8;
      float part[8];
#pragma unroll
      for (int s = 0; s < 8; ++s) {
        const int e = __builtin_amdgcn_readlane(iv, sb + s);
        const u16* ur = UB + (size_t)e * 1024;
        const u32x4 a = *(const u32x4*)(ur + lane * 8);
        const u32x4 b = *(const u32x4*)(ur + 512 + lane * 8);
        part[s] = dot8(b, t1, dot8(a, t0, 0.f));
      }
      float p4[4], p2[2];
#pragma unroll
      for (int i = 0; i < 4; ++i) {
        const float keep = (lane & 32) ? part[i + 4] : part[i];
        const float send = (lane & 32) ? part[i] : part[i + 4];
        p4[i] = keep + __shfl_xor(send, 32);
      }
#pragma unroll
      for (int i = 0; i < 2; ++i) {
        const float keep = (lane & 16) ? p4[i + 2] : p4[i];
        const float send = (lane & 16) ? p4[i] : p4[i + 2];
        p2[i] = keep + __shfl_xor(send, 16);
      }
      float tot;
      {
        const float keep = (lane & 8) ? p2[1] : p2[0];
        const float send = (lane & 8) ? p2[0] : p2[1];
        tot = keep + __shfl_xor(send, 8);
      }
      tot += __shfl_xor(tot, 4);
      tot += __shfl_xor(tot, 2);
      tot += __shfl_xor(tot, 1);
      const float act = gelu_tanh(tot);
      const float mine = __shfl(act, (lane & 7) * 8);
      const bool sel = ((lane >> 3) == (bt & 7));
      if (bt < 8) wlo = sel ? mine * gv : wlo; else whi = sel ? mine * gv : whi;
    }
    float acc[16];
#pragma unroll
    for (int i = 0; i < 16; ++i) acc[i] = 0.f;
#pragma unroll 1
    for (int hf = 0; hf < 2; ++hf) {
      const int iv = hf ? ib : ia;
      const float wv = hf ? whi : wlo;
#pragma unroll 8
      for (int s = 0; s < 64; ++s) {
        const int e = __builtin_amdgcn_readlane(iv, s);
        const float wgt = __uint_as_float(__builtin_amdgcn_readlane(__float_as_uint(wv), s));
        const u16* vr = VB + (size_t)e * 1024;
        const u32x4 a = *(const u32x4*)(vr + lane * 8);
        const u32x4 b = *(const u32x4*)(vr + 512 + lane * 8);
#pragma unroll
        for (int q = 0; q < 4; ++q) {
          acc[2 * q] += wgt * __uint_as_float(a[q] << 16);
          acc[2 * q + 1] += wgt * __uint_as_float(a[q] & 0xffff0000u);
          acc[8 + 2 * q] += wgt * __uint_as_float(b[q] << 16);
          acc[8 + 2 * q + 1] += wgt * __uint_as_float(b[q] & 0xffff0000u);
        }
      }
    }
#endif
    const bool is_lat = tok < NLAT;
    const int bb = is_lat ? (tok >> 12) : 8;
    float* xr = is_lat ? (kp->out + (size_t)tok * 1024) : ((float*)(ws + OFF_XC) + (size_t)(tok - NLAT) * 1024);
    const float* g2 = modl + (size_t)bb * 6144 + 5120;
    float x2[16];
    float ss = 0.f;
#pragma unroll
    for (int hq = 0; hq < 2; ++hq) {
      const int c0 = hq * 512 + lane * 8;
      const f32x4 xa = *(const f32x4*)(xr + c0), xb = *(const f32x4*)(xr + c0 + 4);
      const f32x4 g2a = *(const f32x4*)(g2 + c0), g2b = *(const f32x4*)(g2 + c0 + 4);
#pragma unroll
      for (int j = 0; j < 4; ++j) {
        x2[hq * 8 + j] = xa[j] + g2a[j] * acc[hq * 8 + j];
        x2[hq * 8 + 4 + j] = xb[j] + g2b[j] * acc[hq * 8 + 4 + j];
      }
    }
    if (last) {
#pragma unroll
      for (int i = 0; i < 16; ++i) ss += x2[i] * x2[i];
      ss = wave_sum(ss);
      const float rstd = rsqrtf(ss * (1.0f / 1024.0f) + EPSN);
      const float* fg = kp->in[I_FNG];
#pragma unroll
      for (int hq = 0; hq < 2; ++hq) {
        const int c0 = hq * 512 + lane * 8;
        const f32x4 fa = *(const f32x4*)(fg + c0), fb = *(const f32x4*)(fg + c0 + 4);
#pragma unroll
        for (int j = 0; j < 4; ++j) { x2[hq * 8 + j] *= rstd * fa[j]; x2[hq * 8 + 4 + j] *= rstd * fb[j]; }
      }
    }
#pragma unroll
    for (int hq = 0; hq < 2; ++hq) {
      const int c0 = hq * 512 + lane * 8;
      f32x4 oa, ob;
#pragma unroll
      for (int j = 0; j < 4; ++j) { oa[j] = x2[hq * 8 + j]; ob[j] = x2[hq * 8 + 4 + j]; }
      float* xw = dry ? ((float*)(ws + OFF_QPEER) + (size_t)tok * 1024) : xr;
      *(f32x4*)(xw + c0) = oa;
      *(f32x4*)(xw + c0 + 4) = ob;
    }
  }
}

#endif

#if DEBUG_CHECKS
constexpr size_t OFF_CHK = WS_TOTAL;
constexpr size_t OFF_CHKBUF = WS_TOTAL + 256;
constexpr size_t WS_TOTAL_DBG = OFF_CHKBUF + 64 * 1024 * 4;
__device__ __forceinline__ unsigned hashu(unsigned x) { x ^= x >> 16; x *= 0x7feb352du; x ^= x >> 15; x *= 0x846ca68bu; x ^= x >> 16; return x; }
__device__ __forceinline__ void chk_rep(KP kp, int id, float fast, float ref, float floorv) {
  float err = fabsf(fast - ref) / fmaxf(fabsf(ref), floorv);
  if (!(err == err)) err = 1e9f;
  atomicMax((unsigned*)(kp->ws + OFF_CHK) + id, __float_as_uint(err));
}
__device__ __forceinline__ float rope_ref(float x_self, float x_partner, bool first_half, int pos, int i, int half) {
  const float invf = __powf(10000.0f, -(float)i / (float)half);
  const float ang = (float)pos * invf;
  const float c = __cosf(ang), s = __sinf(ang);
  return first_half ? (x_self * c - x_partner * s) : (x_partner * s + x_self * c);
}
__device__ __forceinline__ void chk_mod(KP kp) {
  const int gt = bidx() * NT + tidx();
  if (gt >= 1024) return;
  const unsigned h = hashu(gt * 7919u + 13u);
  const int l = gt & 1, b = (gt >> 1) % 9, n = h % 6144;
  float v = kp->in[I_BADA][l * 6144 + n];
  for (int k = 0; k < 1024; ++k) {
    const float c = (b < 8) ? kp->in[I_C][b * 1024 + k] : kp->in[I_CCTX][k];
    v += (c / (1.0f + __expf(-c))) * kp->in[I_WADA][(size_t)l * 1024 * 6144 + (size_t)k * 6144 + n];
  }
  chk_rep(kp, 0, ((const float*)(kp->ws + OFF_MOD))[(l * 9 + b) * 6144 + n], v, 0.05f);
}
__device__ __forceinline__ void chk_norm(KP kp, int layer, int id, const float* src_lat, const float* src_ctx, const float* g, int sh_off, int sc_off, int nrows) {
  const int gt = bidx() * NT + tidx();
  if (gt >= 2048) return;
  const unsigned h = hashu(gt * 31u + 7u + id * 1000u);
  const int r = h % nrows, c = (h >> 16) % 1024;
  const float* src = (r < NLAT) ? src_lat + (size_t)r * 1024 : src_ctx + (size_t)(r - NLAT) * 1024;
  float ss = 0.f;
  for (int k = 0; k < 1024; ++k) ss += src[k] * src[k];
  const float rstd = rsqrtf(ss / 1024.0f + EPSN);
  const int bb = (r < NLAT) ? (r >> 12) : 8;
  const float* m = (const float*)(kp->ws + OFF_MOD) + (size_t)(layer * 9 + bb) * 6144;
  const float ref = src[c] * rstd * g[c] * (1.0f + m[sc_off + c]) + m[sh_off + c];
  chk_rep(kp, id, bf2f(((const u16*)(kp->ws + OFF_H))[(size_t)r * 1024 + c]), ref, 0.1f);
}
__device__ __forceinline__ float zproj(KP kp, int layer, int r, int n) {
  const u16* H = (const u16*)(kp->ws + OFF_H) + (size_t)r * 1024;
  const float* w = kp->in[I_WIN] + (size_t)layer * 1024 * 1888 + n;
  float z = 0.f;
  for (int k = 0; k < 1024; ++k) z += bf2f(H[k]) * w[(size_t)k * 1888];
  return z;
}
__device__ __forceinline__ void chk_proj(KP kp, int layer) {
  const int gt = bidx() * NT + tidx();
  if (gt >= 4096) return;
  unsigned char* ws = kp->ws;
  const unsigned h = hashu(gt * 2654435761u + 99u);
  const int r = (gt & 7) == 0 ? (NLAT + (h % NCTX)) : (h % NLAT);
  const int n = (h >> 12) % 1888;
  int b, tk; row_btk(r, b, tk);
  const bool lat = r < NLAT;
  const int rowp = tk >> 6, colp = tk & 63;
  float ref, fast;
  const float z = zproj(kp, layer, r, n);
  if (n < 384 || (n >= 1120 && n < 1632)) {
    int seg0, nh; const u16* base; float scale = 1.0f; bool rope = false;
    if (n < 256) { seg0 = 0; nh = 4; base = (const u16*)(ws + OFF_QA); scale = 0.125f * LOG2E; rope = lat; }
    else if (n < 384) { seg0 = 256; nh = 2; base = (const u16*)(ws + OFF_KA); rope = lat; }
    else if (n < 1376) { seg0 = 1120; nh = 4; base = (const u16*)(ws + OFF_QD); scale = 0.125f * LOG2E; }
    else { seg0 = 1376; nh = 4; base = (const u16*)(ws + OFF_KD); }
    const int head = (n - seg0) >> 6, d = (n - seg0) & 63;
    float v = z;
    if (rope) {
      const int dd = d & 31, i = dd & 15; const bool fh = dd < 16;
      const float zp = zproj(kp, layer, r, fh ? n + 16 : n - 16);
      v = rope_ref(z, zp, fh, (d < 32) ? rowp : colp, i, 16);
    }
    ref = v * scale;
    fast = bf2f(base[((size_t)(b * nh + head) * LK + tk) * 64 + d]);
  } else if ((n >= 384 && n < 512) || n >= 1632) {
    int seg0, nh; const u16* base;
    if (n < 512) { seg0 = 384; nh = 2; base = (const u16*)(ws + OFF_VTA); } else { seg0 = 1632; nh = 4; base = (const u16*)(ws + OFF_VTD); }
    const int head = (n - seg0) >> 6, d = (n - seg0) & 63;
    ref = z; fast = bf2f(base[((size_t)(b * nh + head) * 64 + d) * LK + tk]);
  } else if (n < 704) { ref = z; fast = bf2f(((const u16*)(ws + OFF_CQ))[(size_t)r * 192 + n - 512]); }
  else if (n < 832) { ref = z; fast = bf2f(((const u16*)(ws + OFF_CKV))[(size_t)r * 128 + n - 704]); }
  else if (n < 864) {
    const int d = n - 832; float v = z;
    if (lat) { const int dd = d & 15, i = dd & 7; const bool fh = dd < 8; const float zp = zproj(kp, layer, r, fh ? n + 8 : n - 8); v = rope_ref(z, zp, fh, (d < 16) ? rowp : colp, i, 8); }
    ref = v; fast = bf2f(((const u16*)(ws + OFF_KB))[((size_t)(b * 4 + (h & 3)) * LK + tk) * 96 + 64 + d]);
  } else { ref = z; fast = bf2f(((const u16*)(ws + OFF_U5))[(size_t)r * 256 + n - 864]); }
  chk_rep(kp, 2, fast, ref, 0.15f);
}
__device__ __forceinline__ void chk_mla(KP kp, int layer) {
  const int gt = bidx() * NT + tidx();
  if (gt >= 2048) return;
  unsigned char* ws = kp->ws;
  const unsigned h = hashu(gt * 40503u + 5u);
  const int r = (gt & 7) == 0 ? (NLAT + (h % NCTX)) : (h % NLAT);
  int b, tk; row_btk(r, b, tk);
  const bool lat = r < NLAT;
  if (gt & 1) {
    const int col = (h >> 13) % 384, head = col / 96, dd = col % 96;
    const u16* cq = (const u16*)(ws + OFF_CQ) + (size_t)r * 192;
    float ss = 0.f; for (int k = 0; k < 192; ++k) ss += bf2f(cq[k]) * bf2f(cq[k]);
    const float rstd = rsqrtf(ss / 192.0f + EPSN);
    auto qv = [&](int c) { float a = 0.f; for (int k = 0; k < 192; ++k) a += bf2f(cq[k]) * rstd * kp->in[I_QNG][layer * 192 + k] * kp->in[I_WUQ][(size_t)layer * 192 * 384 + (size_t)k * 384 + c]; return a; };
    float v = qv(col);
    if (dd >= 64 && lat) { const int e = dd - 64, d8 = e & 15, i = d8 & 7; const bool fh = d8 < 8; const float vp = qv(fh ? col + 8 : col - 8); v = rope_ref(v, vp, fh, (e < 16) ? (tk >> 6) : (tk & 63), i, 8); }
    chk_rep(kp, 3, bf2f(((const u16*)(ws + OFF_QB))[((size_t)(b * 4 + head) * LK + tk) * 96 + dd]), v * 0.10206207261596575f * LOG2E, 0.1f);
  } else {
    const int col = (h >> 13) % 512, head = col / 128, w = col % 128;
    const u16* ck = (const u16*)(ws + OFF_CKV) + (size_t)r * 128;
    float ss = 0.f; for (int k = 0; k < 128; ++k) ss += bf2f(ck[k]) * bf2f(ck[k]);
    const float rstd = rsqrtf(ss / 128.0f + EPSN);
    float a = 0.f; for (int k = 0; k < 128; ++k) a += bf2f(ck[k]) * rstd * kp->in[I_KVNG][layer * 128 + k] * kp->in[I_WUKV][(size_t)layer * 128 * 512 + (size_t)k * 512 + col];
    const float fast = (w < 64) ? bf2f(((const u16*)(ws + OFF_KB))[((size_t)(b * 4 + head) * LK + tk) * 96 + w])
                                : bf2f(((const u16*)(ws + OFF_VTB))[((size_t)(b * 4 + head) * 64 + (w - 64)) * LK + tk]);
    chk_rep(kp, 3, fast, a, 0.15f);
  }
}
__device__ __forceinline__ void chk_attn(KP kp, int layer) {
  unsigned char* ws = kp->ws;
  const int lane = tidx() & 63;
  const int gw = (bidx() * NT + tidx()) >> 6, nw = (gridDim.x * NT) >> 6;
  for (int s = gw; s < 768; s += nw) {
    const unsigned h = hashu(s * 977u + 3u);
    const int mixer = s % 3;
    const bool ctxq = (layer == 0) && ((s & 15) == 3);
    const int b = (h >> 3) & 7, head = (h >> 6) & 3, dv = (h >> 8) & 63;
    const int tq = ctxq ? (4096 + ((h >> 14) & 255)) : ((h >> 14) & 4095);
    const int DK = (mixer == 1) ? 96 : 64;
    const u16 *Q, *K, *VT; int ycol; int kvh = head, nkv = 4;
    if (mixer == 0) { Q = (const u16*)(ws + OFF_QA); K = (const u16*)(ws + OFF_KA); VT = (const u16*)(ws + OFF_VTA); ycol = 0; kvh = head >> 1; nkv = 2; }
    else if (mixer == 1) { Q = (const u16*)(ws + OFF_QB); K = (const u16*)(ws + OFF_KB); VT = (const u16*)(ws + OFF_VTB); ycol = 256; }
    else { Q = (const u16*)(ws + OFF_QD); K = (const u16*)(ws + OFF_KD); VT = (const u16*)(ws + OFF_VTD); ycol = 768; }
    const u16* q = Q + ((size_t)(b * 4 + head) * LK + tq) * DK;
    const u16* Kb = K + (size_t)(b * nkv + kvh) * LK * DK;
    const u16* Vb = VT + ((size_t)(b * nkv + kvh) * 64 + dv) * LK;
    const int qr = tq >> 6, qc = tq & 63;
    int r0 = qr - 4; r0 = r0 < 0 ? 0 : (r0 > 56 ? 56 : r0);
    int cs = qc - 8; cs = cs < 0 ? 0 : (cs > 48 ? 48 : cs);
    float mx = -1e30f;
    for (int pass = 0; pass < 2; ++pass) {
      float num = 0.f, den = 0.f;
      for (int k = lane; k < LK; k += 64) {
        bool valid; float bias = 0.f;
        if (k >= 4096) valid = true;
        else if (ctxq) valid = false;
        else if (mixer == 0) { const int d = tq - k; valid = (d <= 128 && d >= -128); }
        else if (mixer == 1) valid = true;
        else { const int kr = k >> 6, kc = k & 63; valid = (kr >= r0 && kr < r0 + 8 && kc >= cs && kc < cs + 16);
               if (valid) bias = kp->in[I_RPB][((size_t)(layer * 4 + head) * 15 + (kr - qr + 7)) * 31 + (kc - qc + 15)] * LOG2E; }
        if (!valid) continue;
        float sc = 0.f;
        for (int d = 0; d < DK; ++d) sc += bf2f(q[d]) * bf2f(Kb[(size_t)k * DK + d]);
        sc += bias;
        if (pass == 0) mx = fmaxf(mx, sc);
        else { const float pr = exp2f(sc - mx); den += pr; num += pr * bf2f(Vb[k]); }
      }
      if (pass == 0) { for (int o = 32; o >= 1; o >>= 1) mx = fmaxf(mx, __shfl_xor(mx, o)); }
      else {
        num = wave_sum(num); den = wave_sum(den);
        if (mixer == 0) den += exp2f(kp->in[I_SINK][layer * 4 + head] * LOG2E - mx);
        const int orow = ctxq ? (NLAT + b * 256 + (tq - 4096)) : (b * 4096 + tq);
        if (lane == 0) chk_rep(kp, 4 + mixer, bf2f(((const u16*)(ws + OFF_H))[(size_t)orow * 1024 + ycol + head * 64 + dv]), num / den, 0.02f);
      }
    }
  }
}
__device__ __forceinline__ void chk_s5(KP kp, int layer, unsigned char* smem) {
  unsigned char* ws = kp->ws;
  if (bidx() >= 8) return;
  const int tid = tidx();
  const unsigned h = hashu(bidx() * 131u + 17u + layer);
  const int b = h & 7, g = (h >> 3) & 15;
  float* ys = (float*)smem;
  for (int i = tid; i < 68 * 16; i += NT) ys[i] = 0.f;
  __syncthreads();
  if (tid < 128) {
    const int dir = tid >> 6, p = tid & 63;
    const int i4 = ((layer * 2 + dir) * 16 + g) * 64 + p;
    const float lr = kp->in[I_LRE][i4], li = kp->in[I_LIM][i4], step = __expf(kp->in[I_LSTEP][(layer * 2 + dir) * 16 + g]);
    const float mag = __expf(lr * step), abr = mag * __cosf(li * step), abi = mag * __sinf(li * step);
    const float nr = abr - 1.0f, ni = abi, den = lr * lr + li * li;
    const float fr = (nr * lr + ni * li) / den, fi = (ni * lr - nr * li) / den;
    float bbr[16], bbi[16];
#pragma unroll
    for (int ch = 0; ch < 16; ++ch) { const float br = kp->in[I_BRE][(size_t)i4 * 16 + ch], bi = kp->in[I_BIM][(size_t)i4 * 16 + ch]; bbr[ch] = fr * br - fi * bi; bbi[ch] = fr * bi + fi * br; }
    float hr = 0.f, hi = 0.f;
    const u16* U5 = (const u16*)(ws + OFF_U5);
    for (int st = 0; st < 4352; ++st) {
      int row, posid;
      if (st < 256) { const int j = dir ? 255 - st : st; row = NLAT + b * 256 + j; posid = 4096 + j; }
      else { const int t = dir ? 4095 - (st - 256) : (st - 256); row = b * 4096 + t; posid = t; }
      float bur = 0.f, bui = 0.f;
#pragma unroll
      for (int ch = 0; ch < 16; ++ch) { const float u = bf2f(U5[(size_t)row * 256 + g * 16 + ch]); bur += bbr[ch] * u; bui += bbi[ch] * u; }
      const float nhr = abr * hr - abi * hi + bur, nhi = abr * hi + abi * hr + bui;
      hr = nhr; hi = nhi;
      if ((posid & 63) == 37) {
        const int sidx = posid >> 6;
        for (int cp = 0; cp < 16; ++cp) {
          const int ci = (((layer * 2 + dir) * 16 + g) * 16 + cp) * 64 + p;
          atomicAdd(&ys[sidx * 16 + cp], kp->in[I_CRE][ci] * hr - kp->in[I_CIM][ci] * hi);
        }
      }
    }
  }
  __syncthreads();
  for (int i = tid; i < 68 * 16; i += NT) {
    const int sidx = i >> 4, cp = i & 15;
    const int posid = sidx * 64 + 37;
    const int row = (posid < 4096) ? (b * 4096 + posid) : (NLAT + b * 256 + (posid - 4096));
    if (layer == 1 && posid >= 4096) continue;
    const float u = bf2f(((const u16*)(ws + OFF_U5))[(size_t)row * 256 + g * 16 + cp]);
    const float y = ys[i] + kp->in[I_S5D][layer * 256 + g * 16 + cp] * u;
    chk_rep(kp, 7, bf2f(((const u16*)(ws + OFF_YG))[(size_t)row * 256 + g * 16 + cp]), gelu_tanh(y), 0.05f);
  }
  __syncthreads();
}
__device__ __forceinline__ void chk_glu(KP kp, int layer) {
  const int gt = bidx() * NT + tidx();
  if (gt >= 2048) return;
  const unsigned h = hashu(gt * 7u + 1u);
  const int r = h % NLAT, c = (h >> 16) & 255;
  const u16* yg = (const u16*)(kp->ws + OFF_YG) + (size_t)r * 256;
  const float* w = kp->in[I_WGLU] + (size_t)layer * 256 * 512;
  float a = 0.f, gg = 0.f;
  for (int k = 0; k < 256; ++k) { a += bf2f(yg[k]) * w[k * 512 + c]; gg += bf2f(yg[k]) * w[k * 512 + 256 + c]; }
  chk_rep(kp, 8, bf2f(((const u16*)(kp->ws + OFF_H))[(size_t)r * 1024 + 512 + c]), a / (1.0f + __expf(-gg)), 0.05f);
}
__device__ __forceinline__ void chk_gn(KP kp) {
  const int gt = bidx() * NT + tidx();
  if (gt >= 2048) return;
  const unsigned h = hashu(gt * 13u + 2u);
  const int r = h % NLAT, grp = (h >> 20) & 3;
  const u16* y = (const u16*)(kp->ws + OFF_H) + (size_t)r * 1024 + grp * 256;
  float ss = 0.f; for (int k = 0; k < 256; ++k) ss += bf2f(y[k]) * bf2f(y[k]);
  chk_rep(kp, 9, ss / 256.0f, 1.0f, 1.0f);
}
__device__ __forceinline__ void chk_out(KP kp, int layer) {
  if (layer != 0) return;
  const int gt = bidx() * NT + tidx();
  if (gt >= 2048) return;
  const unsigned h = hashu(gt * 17u + 4u);
  const int r = (gt & 7) == 0 ? (NLAT + (h % NCTX)) : (h % NLAT), n = (h >> 16) & 1023;
  const u16* y = (const u16*)(kp->ws + OFF_H) + (size_t)r * 1024;
  float a = 0.f;
  for (int k = 0; k < 1024; ++k) a += bf2f(y[k]) * kp->in[I_MIXG][layer * 1024 + k] * kp->in[I_WOUT][(size_t)layer * 1024 * 1024 + (size_t)k * 1024 + n];
  const int bb = (r < NLAT) ? (r >> 12) : 8;
  const float g1 = ((const float*)(kp->ws + OFF_MOD))[(size_t)(layer * 9 + bb) * 6144 + 2048 + n];
  const float xin = (r < NLAT) ? kp->in[I_X][(size_t)r * 1024 + n] : kp->in[I_CTX][(size_t)(r - NLAT) * 1024 + n];
  const float fast = (r < NLAT) ? kp->out[(size_t)r * 1024 + n] : ((const float*)(kp->ws + OFF_XC))[(size_t)(r - NLAT) * 1024 + n];
  chk_rep(kp, 10, fast - xin, g1 * a, 0.05f);
}
__device__ __forceinline__ void chk_q(KP kp, int layer) {
  const int gt = bidx() * NT + tidx();
  if (gt >= 2048) return;
  const unsigned h = hashu(gt * 19u + 6u);
  const int r = h % NLAT, n = (h >> 16) & 2047;
  const u16* hh = (const u16*)(kp->ws + OFF_H) + (size_t)r * 1024;
  float a = 0.f;
  for (int k = 0; k < 1024; ++k) a += bf2f(hh[k]) * kp->in[I_PWQ][(size_t)layer * 1024 * 2048 + (size_t)k * 2048 + n];
  chk_rep(kp, 11, bf2f(((const u16*)(kp->ws + OFF_QPEER))[(size_t)r * 2048 + n]), a, 0.15f);
}
__device__ __forceinline__ void chk_topk(KP kp, int layer, unsigned char* smem) {
  const int tid = tidx();
  if (bidx() >= 16) return;
  float* s = (float*)smem;
  if (tid < 16) {
    const unsigned h = hashu((bidx() * 16 + tid) * 23u + 8u);
    const int r = h % NLAT, head = (h >> 16) & 7;
    float* s1 = s + tid * 1024; float* s2 = s1 + 128; float* cs_ = s1 + 256; int* ci_ = (int*)(s1 + 512);
    const u16* q = (const u16*)(kp->ws + OFF_QPEER) + (size_t)r * 2048 + head * 256;
    for (int k = 0; k < 128; ++k) {
      float a = 0.f, b2 = 0.f;
      for (int d = 0; d < 128; ++d) {
        a += bf2f(q[d]) * kp->in[I_SUBK][((size_t)(layer * 2 + 0) * 128 + k) * 128 + d];
        b2 += bf2f(q[128 + d]) * kp->in[I_SUBK][((size_t)(layer * 2 + 1) * 128 + k) * 128 + d];
      }
      s1[k] = a; s2[k] = b2;
    }
    float* v1 = s1 + 768; float* v2 = s1 + 784; int* i1 = (int*)(s1 + 800); int* i2 = (int*)(s1 + 816); float* tv = s1 + 832; int* te = (int*)(s1 + 848);
    for (int t = 0; t < 16; ++t) { int bi = 0; float bv = -3e38f; for (int k = 0; k < 128; ++k) if (s1[k] > bv) { bv = s1[k]; bi = k; } v1[t] = bv; i1[t] = bi; s1[bi] = -3e38f; }
    for (int t = 0; t < 16; ++t) { int bi = 0; float bv = -3e38f; for (int k = 0; k < 128; ++k) if (s2[k] > bv) { bv = s2[k]; bi = k; } v2[t] = bv; i2[t] = bi; s2[bi] = -3e38f; }
    for (int a = 0; a < 16; ++a) for (int b2 = 0; b2 < 16; ++b2) { cs_[a * 16 + b2] = v1[a] + v2[b2]; ci_[a * 16 + b2] = i1[a] * 128 + i2[b2]; }
    for (int t = 0; t < 16; ++t) { int bi = 0; float bv = -3e38f; for (int k = 0; k < 256; ++k) if (cs_[k] > bv) { bv = cs_[k]; bi = k; } tv[t] = bv; te[t] = ci_[bi]; cs_[bi] = -3e38f; }
    const float tmax = tv[0];
    float sum = 0.f; for (int t = 0; t < 16; ++t) { tv[t] = __expf(tv[t] - tmax); sum += tv[t]; }
    const u16* IDX = (const u16*)(kp->ws + OFF_IDX) + ((size_t)r * 8 + head) * 16;
    const float* GATE = (const float*)(kp->ws + OFF_GATE) + ((size_t)r * 8 + head) * 16;
    float err = 0.f;
    for (int t = 0; t < 16; ++t) {
      float gf = 0.f;
      for (int u = 0; u < 16; ++u) if (IDX[u] == te[t]) gf = GATE[u];
      err += fabsf(gf - tv[t] / sum);
    }
    chk_rep(kp, 12, err, 0.f, 1.0f);
  }
}
__device__ __forceinline__ void chk_peer_a(KP kp, int layer) {
  unsigned char* ws = kp->ws;
  const int lane = tidx() & 63;
  const int gw = (bidx() * NT + tidx()) >> 6;
  if (gw >= 64) return;
  {
    const unsigned hh = hashu((gw * 64 + lane) * 37u + 11u);
    const size_t ei = (size_t)(hh % (16384u * 1024u));
    chk_rep(kp, 15, bf2f(((const u16*)(ws + OFF_UB))[ei]), kp->in[I_PU][(size_t)layer * 16384 * 1024 + ei], 0.01f);
    chk_rep(kp, 16, bf2f(((const u16*)(ws + OFF_VB))[ei]), kp->in[I_PV][(size_t)layer * 16384 * 1024 + ei], 0.3f);
  }
  const int tok = hashu(gw * 29u + 9u + layer) % NLAT;
  const u16* hrow = (const u16*)(ws + OFF_H) + (size_t)tok * 1024;
  const u16* IDX = (const u16*)(ws + OFF_IDX) + (size_t)tok * 128;
  const float* GATE = (const float*)(ws + OFF_GATE) + (size_t)tok * 128;
  float acc[16];
  _Pragma("unroll") for (int i = 0; i < 16; ++i) acc[i] = 0.f;
  for (int s = 0; s < 128; ++s) {
    const int e = IDX[s];
    const float* ur = kp->in[I_PU] + ((size_t)layer * 16384 + e) * 1024;
    const float* vr = kp->in[I_PV] + ((size_t)layer * 16384 + e) * 1024;
    float d = 0.f;
    _Pragma("unroll") for (int i = 0; i < 16; ++i) d += bf2f(hrow[lane + 64 * i]) * ur[lane + 64 * i];
    d = wave_sum(d);
    const float w = GATE[s] * gelu_tanh(d);
    _Pragma("unroll") for (int i = 0; i < 16; ++i) acc[i] += w * vr[lane + 64 * i];
  }
  const float* g2 = (const float*)(ws + OFF_MOD) + (size_t)(layer * 9 + (tok >> 12)) * 6144 + 5120;
  float x2[16]; float ss = 0.f;
  _Pragma("unroll") for (int i = 0; i < 16; ++i) { x2[i] = kp->out[(size_t)tok * 1024 + lane + 64 * i] + g2[lane + 64 * i] * acc[i]; ss += x2[i] * x2[i]; }
  if (layer == 1) { ss = wave_sum(ss); const float rstd = rsqrtf(ss / 1024.0f + EPSN); _Pragma("unroll") for (int i = 0; i < 16; ++i) x2[i] *= rstd * kp->in[I_FNG][lane + 64 * i]; }
  float* cb = (float*)(ws + OFF_CHKBUF) + (size_t)gw * 1024;
  _Pragma("unroll") for (int i = 0; i < 16; ++i) cb[lane + 64 * i] = x2[i];
}
__device__ __forceinline__ void chk_peer_b(KP kp, int layer) {
  const int lane = tidx() & 63;
  const int gw = (bidx() * NT + tidx()) >> 6;
  if (gw >= 64) return;
  const int tok = hashu(gw * 29u + 9u + layer) % NLAT;
  const float* cb = (const float*)(kp->ws + OFF_CHKBUF) + (size_t)gw * 1024;
  _Pragma("unroll") for (int i = 0; i < 16; ++i) {
    const float fa = kp->out[(size_t)tok * 1024 + lane + 64 * i], rf = cb[lane + 64 * i];
    chk_rep(kp, 13, fa, rf, 0.3f);
    if (fabsf(fa - rf) > 0.03f) atomicAdd((float*)(kp->ws + OFF_CHK) + 17, 1.0f / 65536.0f);
  }
}
__device__ __forceinline__ void chk_final(KP kp) {
  const float* e = (const float*)(kp->ws + OFF_CHK);
  float v;
  if (DEBUG_ONE < 0) {
    int mask = 0;
    for (int i = 0; i < 6; ++i) { const float x = e[DEBUG_SEL * 6 + i]; if (!(x <= DEBUG_TOL)) mask |= (1 << i); }
    v = sqrtf((float)(1 + mask) * 100.0f);
  } else {
    v = sqrtf(1.0e4f * fminf(e[DEBUG_ONE], 1.0e6f));
  }
  const int gt = bidx() * NT + tidx(), gn = gridDim.x * NT;
  for (int i = gt; i < NLAT * 1024; i += gn) kp->out[i] = v;
}
#endif
__device__ __forceinline__ KP fresh_params() {
  KP kp = (KP)__builtin_amdgcn_kernarg_segment_ptr();
  asm volatile("" : "+s"(kp));
  return kp;
}
#define GS_CG() do { asm volatile("s_waitcnt vmcnt(0)" ::: "memory"); grid.sync(); __builtin_amdgcn_fence(__ATOMIC_ACQUIRE, "agent"); asm volatile("s_waitcnt vmcnt(0)" ::: "memory"); } while (0)
#define GS() xcd_barrier((unsigned*)(fresh_params()->ws + OFF_BAR), xb_st)
#if DEBUG_CHECKS
#define CHK(x) do { if (layer == DEBUG_LAYER) { x; GS(); } } while (0)
#else
#define CHK(x) do { } while (0)
#endif
__global__ void __launch_bounds__(NT, 2) mega_kernel(Params p_unused) {
  __shared__ __attribute__((aligned(16))) unsigned char smem[SMEM_BYTES];
  cg::grid_group grid = cg::this_grid();
  volatile LAS unsigned* xb_st = (volatile LAS unsigned*)(smem + SMEM_BYTES - 16);
  {
    unsigned* barp0 = (unsigned*)(fresh_params()->ws + OFF_BAR);
    if (threadIdx.x == 0) {
      xb_st[0] = 0u; xb_st[1] = 0u;
      (void)xb_add(barp0 + XB_XCNT(xb_xcc_id()), 1u);
    }
  }
  __syncthreads();
#if DEBUG_CHECKS
  if (bidx() == 0 && tidx() < 64) ((unsigned*)(fresh_params()->ws + OFF_CHK))[tidx()] = 0u;
#endif
#if NAN_POISON
  {
    KP kp = fresh_params();
    u32x4* w4 = (u32x4*)kp->ws; u32x4* o4 = (u32x4*)kp->out;
    const u32x4 pz = {0x7FC07FC0u, 0x7FC07FC0u, 0x7FC07FC0u, 0x7FC07FC0u};
    const size_t gt = (size_t)bidx() * NT + tidx(), gn = (size_t)gridDim.x * NT;
    for (size_t i = gt; i < WS_TOTAL / 16; i += gn) w4[i] = pz;
    for (size_t i = gt; i < (size_t)NLAT * 1024 / 4; i += gn) o4[i] = pz;
  }
  GS();
#endif
  phase0(fresh_params(), smem); GS_CG();
  if (REP_PHASE == 20) { phase0(fresh_params(), smem); GS(); }
#if DEBUG_CHECKS
  chk_mod(fresh_params()); GS();
#endif
#define RUN(n, call) do { for (int rep_ = 0; rep_ < ((REP_PHASE == (n)) ? 2 : 1); ++rep_) { call; GS(); } } while (0)
#pragma unroll 1
  for (int layer = 0; layer < 2; ++layer) {
    RUN(1, phase1(fresh_params(), layer));
    CHK(chk_norm(fresh_params(), layer, 1, (layer == 0) ? fresh_params()->in[I_X] : fresh_params()->out,
                 (layer == 0) ? fresh_params()->in[I_CTX] : (const float*)(fresh_params()->ws + OFF_XC), fresh_params()->in[I_N1G] + layer * 1024, 0, 1024, MTOT));
    RUN(2, phase2(fresh_params(), layer, smem));
    CHK(chk_proj(fresh_params(), layer));
    RUN(3, phase3(fresh_params(), layer, smem));
    CHK(chk_mla(fresh_params(), layer));
    RUN(4, phase4(fresh_params(), layer, smem));
    if (REP_PHASE == 5) { phase5(fresh_params(), layer, smem, REP_SUB); GS(); }
    phase5(fresh_params(), layer, smem); GS();
    CHK(chk_attn(fresh_params(), layer));
    CHK(chk_s5(fresh_params(), layer, smem));
    RUN(6, phase6(fresh_params(), layer, smem));
    CHK(chk_glu(fresh_params(), layer));
    CHK(chk_gn(fresh_params()));
    if (REP_PHASE == 8 && layer == 0) { phase8(fresh_params(), layer, smem); GS(); }
    phase8(fresh_params(), layer, smem); GS();
    CHK(chk_out(fresh_params(), layer));
    RUN(9, phase9(fresh_params(), layer));
    CHK(chk_norm(fresh_params(), layer, 14, fresh_params()->out, (const float*)(fresh_params()->ws + OFF_XC), fresh_params()->in[I_N2G] + layer * 1024, 3072, 4096, NLAT));
    RUN(10, phase10(fresh_params(), layer, smem));
    CHK(chk_q(fresh_params(), layer));
    RUN(11, phase11(fresh_params(), layer, smem));
    CHK(chk_topk(fresh_params(), layer, smem));
    CHK(chk_peer_a(fresh_params(), layer));
    RUN(12, phase12a(fresh_params(), layer));
    RUN(13, phase12b(fresh_params(), layer));
    RUN(14, phase12c(fresh_params(), layer));
    if (layer == 1) phase13(fresh_params());
    CHK(chk_peer_b(fresh_params(), layer));
  }
#if DEBUG_CHECKS
  chk_final(fresh_params());
#endif
}

extern "C" void kernel_launch(void* const* d_in, const int* in_sizes, int n_in, void* d_out, int out_size, void* d_ws, size_t ws_size,
                              hipStream_t stream) {
  static int grid_blocks = 0;
  if (!grid_blocks) {
    int dev = 0, cus = 0, per_cu = 0;
    (void)hipGetDevice(&dev);
    (void)hipDeviceGetAttribute(&cus, hipDeviceAttributeMultiprocessorCount, dev);
    (void)hipOccupancyMaxActiveBlocksPerMultiprocessor(&per_cu, mega_kernel, NT, 0);
    if (per_cu > 2) per_cu = 2;
    if (per_cu < 1) per_cu = 1;
    grid_blocks = cus * per_cu;
    if (ws_size < WS_TOTAL) fprintf(stderr, "kernel_launch: workspace too small: %zu < %zu\n", ws_size, (size_t)WS_TOTAL);
  }
  if (ws_size < WS_TOTAL + (DEBUG_CHECKS ? (1 << 20) : 0) || n_in != 31) return;
  Params p{};
  for (int i = 0; i < 31; ++i) p.in[i] = (const float*)d_in[i];
  p.out = (float*)d_out;
  p.ws = (unsigned char*)d_ws;
  (void)hipMemsetAsync((unsigned char*)d_ws + OFF_BAR, 0, BAR_BYTES, stream);
  void* args[] = {&p};
  hipError_t e = hipLaunchCooperativeKernel((void*)mega_kernel, dim3(grid_blocks), dim3(NT), args, 0, stream);
  if (e != hipSuccess) fprintf(stderr, "cooperative launch failed: %s (grid %d)\n", hipGetErrorString(e), grid_blocks);
}
```

```cpp
#include <hip/hip_runtime.h>
#include <hip/hip_bf16.h>
#include <hip/hip_cooperative_groups.h>
#include <cstdio>
#include <cstdint>
namespace cg = cooperative_groups;

typedef unsigned short u16;
typedef __attribute__((ext_vector_type(8))) short bf16x8;
typedef __attribute__((ext_vector_type(4))) float f32x4;
typedef __attribute__((ext_vector_type(16))) float f32x16;
typedef __attribute__((ext_vector_type(4))) unsigned u32x4;
typedef __attribute__((ext_vector_type(2))) unsigned u32x2;
typedef __attribute__((ext_vector_type(2))) __bf16 bf16x2_t;

#define NT 256
#ifndef DEBUG_CHECKS
#define DEBUG_CHECKS 0
#endif
#define DEBUG_LAYER 0
#define ATT_T15 1
#define ONLY34 0
#define REP_PHASE 0
#define ATT_DUP 0
#define REP_SUB 0
#define NAN_POISON 0
#define PEER_SIMPLE 0
#define PEER_OLD 0
#define DEBUG_SEL 2
#define DEBUG_TOL 0.08f
#define DEBUG_ONE 13
constexpr int NB = 8, SEQL = 4096, CTXL = 256, LK = 4352, DM = 1024;
constexpr int NLAT = NB * SEQL, NCTX = NB * CTXL, MTOT = NLAT + NCTX;
constexpr int NWIN = 1920;
constexpr float LOG2E = 1.4426950408889634f;
constexpr float EPSN = 1e-6f;
constexpr int SMEM_BYTES = 76800;

constexpr size_t al256(size_t x) { return (x + 255) / 256 * 256; }
constexpr size_t OFF_WINT = 0;
constexpr size_t OFF_WUQT = OFF_WINT + al256((size_t)2 * NWIN * 1024 * 2);
constexpr size_t OFF_WUKVT = OFF_WUQT + al256((size_t)2 * 384 * 192 * 2);
constexpr size_t OFF_WGLUT = OFF_WUKVT + al256((size_t)2 * 512 * 128 * 2);
constexpr size_t OFF_WOUTT = OFF_WGLUT + al256((size_t)2 * 512 * 256 * 2);
constexpr size_t OFF_WQT = OFF_WOUTT + al256((size_t)2 * 1024 * 1024 * 2);
constexpr size_t OFF_SUBK = OFF_WQT + al256((size_t)2 * 2048 * 1024 * 2);
constexpr size_t OFF_UB = OFF_SUBK + al256((size_t)2 * 2 * 128 * 128 * 2);
constexpr size_t OFF_VB = OFF_UB + al256((size_t)16384 * 1024 * 2);
constexpr size_t OFF_MODP = OFF_VB + al256((size_t)16384 * 1024 * 2);
constexpr size_t OFF_MOD = OFF_MODP + al256((size_t)2 * 8 * 9 * 6144 * 4);
constexpr size_t OFF_ROPE16 = OFF_MOD + al256((size_t)2 * 9 * 6144 * 4);
constexpr size_t OFF_ROPE8 = OFF_ROPE16 + al256((size_t)64 * 16 * 8);
constexpr size_t OFF_APOW = OFF_ROPE8 + al256((size_t)64 * 8 * 8);
constexpr size_t OFF_BBAR = OFF_APOW + al256((size_t)2 * 2 * 16 * 64 * 65 * 8);
constexpr size_t OFF_KTAB = OFF_BBAR + al256((size_t)2 * 2 * 16 * 64 * 16 * 8);
constexpr size_t OFF_W1 = OFF_KTAB + al256((size_t)2 * 16 * 2 * 64 * 256 * 4);
constexpr size_t OFF_M3 = OFF_W1 + al256((size_t)2 * 2 * 16 * 128 * 1024 * 2);
constexpr size_t OFF_WQ8 = OFF_UB + (size_t)16 * 1024 * 1024;
constexpr size_t OFF_WIN8 = OFF_WQ8 + (size_t)4 * 1024 * 1024;
constexpr size_t OFF_TS1 = OFF_WIN8 + (size_t)4 * 1024 * 1024;
constexpr size_t OFF_WOUT8 = OFF_TS1 + (size_t)1024 * 1024;
constexpr float WQ8_SCALE = 127.0f * 32.0f / 6.0f;
constexpr size_t OFF_H8 = OFF_M3;
constexpr size_t OFF_TS = OFF_M3 + (size_t)36 * 1024 * 1024;
constexpr size_t OFF_H = OFF_M3 + al256((size_t)16 * 1024 * 1280 * 2);
constexpr size_t OFF_MIX = OFF_H + al256((size_t)MTOT * 1024 * 2);
constexpr size_t OFF_QA = OFF_MIX;
constexpr size_t OFF_KA = OFF_QA + al256((size_t)NB * 4 * LK * 64 * 2);
constexpr size_t OFF_VTA = OFF_KA + al256((size_t)NB * 2 * LK * 64 * 2);
constexpr size_t OFF_CQ = OFF_VTA + al256((size_t)NB * 2 * LK * 64 * 2);
constexpr size_t OFF_CKV = OFF_CQ + al256((size_t)MTOT * 192 * 2);
constexpr size_t OFF_QB = OFF_CKV + al256((size_t)MTOT * 128 * 2);
constexpr size_t OFF_KB = OFF_QB + al256((size_t)NB * 4 * LK * 96 * 2);
constexpr size_t OFF_VTB = OFF_KB + al256((size_t)NB * 4 * LK * 96 * 2);
constexpr size_t OFF_U5 = OFF_VTB + al256((size_t)NB * 4 * LK * 64 * 2);
constexpr size_t OFF_QD = OFF_U5 + al256((size_t)MTOT * 256 * 2);
constexpr size_t OFF_KD = OFF_QD + al256((size_t)NB * 4 * LK * 64 * 2);
constexpr size_t OFF_VTD = OFF_KD + al256((size_t)NB * 4 * LK * 64 * 2);
constexpr size_t OFF_MIXEND = OFF_VTD + al256((size_t)NB * 4 * LK * 64 * 2);
constexpr size_t OFF_QPEER = OFF_MIX;
constexpr size_t QPEER_END = OFF_QPEER + al256((size_t)MTOT * 2048 * 2);
constexpr size_t OFF_S5S = (OFF_MIXEND > QPEER_END ? OFF_MIXEND : QPEER_END);
constexpr size_t OFF_HIN = OFF_S5S + al256((size_t)544 * 16 * 2 * 128 * 4);
constexpr size_t OFF_YG = OFF_HIN + al256((size_t)544 * 16 * 256 * 2);
constexpr size_t OFF_XC = OFF_YG + al256((size_t)MTOT * 256 * 2);
constexpr size_t OFF_IDX = OFF_XC + al256((size_t)NCTX * 1024 * 4);
constexpr size_t OFF_GATE = OFF_IDX + al256((size_t)MTOT * 128 * 4);
constexpr size_t OFF_H8A = OFF_IDX;
constexpr size_t OFF_BAR = OFF_GATE + al256((size_t)MTOT * 128 * 4);
constexpr size_t BAR_BYTES = 16384;
constexpr size_t WS_TOTAL = OFF_BAR + BAR_BYTES;

struct Params {
  const float* in[31];
  float* out;
  unsigned char* ws;
};
typedef const __attribute__((address_space(4))) Params* KP;
enum { I_X = 0, I_C, I_CTX, I_CCTX, I_N1G, I_N2G, I_WADA, I_BADA, I_WIN, I_SINK, I_QNG, I_WUQ, I_KVNG, I_WUKV,
       I_LRE, I_LIM, I_LSTEP, I_BRE, I_BIM, I_CRE, I_CIM, I_S5D, I_WGLU, I_RPB, I_MIXG, I_WOUT, I_PWQ, I_SUBK, I_PU, I_PV, I_FNG };

__device__ __forceinline__ int tidx() { int t = threadIdx.x; asm volatile("" : "+v"(t)); return t; }
__device__ __forceinline__ int bidx() { int b = blockIdx.x; asm volatile("" : "+s"(b)); return b; }
__device__ __forceinline__ u16 f2bf(float f) { __hip_bfloat16 b = __float2bfloat16(f); return *reinterpret_cast<u16*>(&b); }
__device__ __forceinline__ float bf2f(u16 v) { return __uint_as_float(((unsigned)v) << 16); }
typedef __attribute__((ext_vector_type(2))) float f32x2_;
typedef __attribute__((ext_vector_type(2))) __bf16 bf16x2v_;
__device__ __forceinline__ unsigned pack2(float lo, float hi) { const f32x2_ v = {lo, hi}; return __builtin_bit_cast(unsigned, __builtin_convertvector(v, bf16x2v_)); }
__device__ __forceinline__ float gelu_tanh(float x) {
  const float u = 0.7978845608028654f * (x + 0.044715f * x * x * x);
  const float e = __expf(2.0f * u);
  const float t = 1.0f - 2.0f * __builtin_amdgcn_rcpf(e + 1.0f);
  return 0.5f * x * (1.0f + t);
}
__device__ __forceinline__ float sigmoidf_(float x) { return __builtin_amdgcn_rcpf(1.0f + __expf(-x)); }
__device__ __forceinline__ void row_btk(int r, int& b, int& tk) {
  if (r < NLAT) { b = r >> 12; tk = r & 4095; } else { const int q = r - NLAT; b = q >> 8; tk = 4096 + (q & 255); }
}
__device__ __forceinline__ f32x4 mfma16(bf16x8 a, bf16x8 b, f32x4 c) { return __builtin_amdgcn_mfma_f32_16x16x32_bf16(a, b, c, 0, 0, 0); }
__device__ __forceinline__ f32x16 mfma32(bf16x8 a, bf16x8 b, f32x16 c) { return __builtin_amdgcn_mfma_f32_32x32x16_bf16(a, b, c, 0, 0, 0); }
__device__ __forceinline__ float wave_sum(float v) {
#pragma unroll
  for (int o = 32; o >= 1; o >>= 1) v += __shfl_xor(v, o);
  return v;
}
__device__ __forceinline__ float2 cmul(float2 a, float2 b) { return make_float2(a.x * b.x - a.y * b.y, a.x * b.y + a.y * b.x); }


#define XB_TMO      128
#define XB_XCNT(j)  (256  + 64 * (j))
#define XB_XSUB(j)  (1280 + 64 * (j))
#define XB_XGEN(j)  (2304 + 64 * (j))
#define XB_TOP      3328
#define XB_TOPGEN   3392
#define XB_QUEUE(j) (3584 + 16 * (j))
#define XB_SPIN_CAP (1u << 22)
#define LAS __attribute__((address_space(3)))
__device__ __forceinline__ unsigned xb_ld(unsigned* p) { return __hip_atomic_load(p, __ATOMIC_RELAXED, __HIP_MEMORY_SCOPE_AGENT); }
__device__ __forceinline__ unsigned xb_add(unsigned* p, unsigned v) { return __hip_atomic_fetch_add(p, v, __ATOMIC_RELAXED, __HIP_MEMORY_SCOPE_AGENT); }
__device__ __forceinline__ unsigned xb_xcc_id() { return (unsigned)__builtin_amdgcn_s_getreg((3 << 11) | 20) & 0xFu; }
#define XB_SPIN(cond, bar) do { unsigned _sp = 0; while (cond) { __builtin_amdgcn_s_sleep(1); \
    if ((++_sp & 255u) == 0u) { if (xb_ld(&(bar)[XB_TMO])) break; if (_sp > XB_SPIN_CAP) { atomicAdd(&(bar)[XB_TMO], 1u); break; } } } } while (0)
__device__ __forceinline__ void xcd_barrier_complete(unsigned* bar, unsigned x, unsigned& nloc, unsigned& nx) {
  const unsigned G = gridDim.x;
  unsigned sum, cnt, mine, sp = 0u;
  for (;;) {
    sum = 0u; cnt = 0u; mine = 0u;
#pragma unroll
    for (unsigned j = 0; j < 16; ++j) { const unsigned c = xb_ld(&bar[XB_XCNT(j)]); sum += c; cnt += (c > 0u) ? 1u : 0u; mine = (j == x) ? c : mine; }
    if (sum == G) break;
    __builtin_amdgcn_s_sleep(1);
    if ((++sp & 255u) == 0u) { if (xb_ld(&bar[XB_TMO])) break; if (sp > XB_SPIN_CAP) { atomicAdd(&bar[XB_TMO], 1u); break; } }
  }
  nloc = mine > 0u ? mine : 1u; nx = cnt > 0u ? cnt : 1u;
}
__device__ __forceinline__ void xcd_barrier(unsigned* bar, volatile LAS unsigned* st) {
  asm volatile("s_waitcnt vmcnt(0)" ::: "memory");
  __syncthreads();
  if (threadIdx.x == 0) {
    const unsigned x = xb_xcc_id();
    __builtin_amdgcn_s_waitcnt(0);
    unsigned nloc = st[0], nx = st[1];
    if (nloc == 0u) { xcd_barrier_complete(bar, x, nloc, nx); st[0] = nloc; st[1] = nx; }
    const unsigned old = xb_add(&bar[XB_XSUB(x)], 1u);
    const unsigned gen = old / nloc;
    if (old + 1u == (gen + 1u) * nloc) {
      __builtin_amdgcn_fence(__ATOMIC_RELEASE, "agent");
      asm volatile("s_waitcnt vmcnt(0)" ::: "memory");
      const unsigned og = xb_add(&bar[XB_TOP], 1u);
      const unsigned tg = og / nx;
      if (og + 1u == (tg + 1u) * nx) xb_add(&bar[XB_TOPGEN], 1u);
      else XB_SPIN(xb_ld(&bar[XB_TOPGEN]) == tg, bar);
      __builtin_amdgcn_fence(__ATOMIC_ACQUIRE, "agent");
      xb_add(&bar[XB_XGEN(x)], 1u);
      asm volatile("s_waitcnt vmcnt(0)" ::: "memory");
    } else {
      XB_SPIN(xb_ld(&bar[XB_XGEN(x)]) == gen, bar);
      __builtin_amdgcn_fence(__ATOMIC_ACQUIRE, "agent");
      asm volatile("s_waitcnt vmcnt(0)" ::: "memory");
    }
  }
  __syncthreads();
}
__device__ __forceinline__ void transpose_tile(const float* __restrict__ src, int K, int N, u16* __restrict__ dst, int kt, int nt, int mapmode,
                               const float* __restrict__ kscale, unsigned char* smem, int kb_rows = 0,
                               signed char* __restrict__ dst8 = nullptr, float q8s = 0.f) {
  float* tile = (float*)smem;
  const int tid = tidx();
  __syncthreads();
  {
    const int nn = tid & 63;
    const int np = nt * 64 + nn;
    int n;
    if (mapmode == 1) n = (np < 864) ? np : (np < 896 ? -1 : np - 32);
    else if (mapmode == 2) { const int blk = np >> 5, w = np & 31; n = (w < 16) ? (blk * 16 + w) : (256 + blk * 16 + (w - 16)); }
    else n = np;
#pragma unroll
    for (int i = 0; i < 16; ++i) {
      const int kk = i * 4 + (tid >> 6);
      const int k = kt * 64 + kk;
      float v = 0.f;
      if (n >= 0 && k < K) v = src[(size_t)k * N + n];
      tile[kk * 65 + nn] = v;
    }
  }
  __syncthreads();
  {
    const int kk = tid & 63;
    const int k = kt * 64 + kk;
    if (k < K) {
      const float sc = kscale ? kscale[k] : 1.0f;
#pragma unroll
      for (int i = 0; i < 16; ++i) {
        const int nn = i * 4 + (tid >> 6);
        const size_t di = kb_rows ? (((size_t)(k >> 5) * kb_rows + (nt * 64 + nn)) * 32 + (k & 31)) : ((size_t)(nt * 64 + nn) * K + k);
        if (dst8) dst8[di] = (signed char)(int)rintf(fminf(fmaxf(tile[kk * 65 + nn] * sc * q8s, -127.0f), 127.0f));
        else dst[di] = f2bf(tile[kk * 65 + nn] * sc);
      }
    }
  }
}

__device__ __forceinline__ float2 apow_calc(float lr, float li, float step, int m) {
  const float mag = __expf(lr * step * (float)m);
  double rev = (double)li * (double)step * (double)m * 0.15915494309189535;
  rev -= rint(rev);
  const float r = (float)rev;
  return make_float2(mag * __builtin_amdgcn_cosf(r), mag * __builtin_amdgcn_sinf(r));
}

__device__ __forceinline__ void phase0(KP kp, unsigned char* smem) {
  unsigned char* ws = kp->ws;
  const int tid = tidx();
  constexpr int N_ADA = 2 * 96;
  constexpr int N_WIN = 2 * 30 * 16;
  constexpr int N_WOUT = 2 * 16 * 16;
  constexpr int N_WQ = 2 * 32 * 16;
  constexpr int N_WUQ = 2 * 6 * 3;
  constexpr int N_WUKV = 2 * 8 * 2;
  constexpr int N_WGLU = 2 * 8 * 4;
  constexpr int N_SUBK = 256;
  constexpr int N_APOW = 1040;
  constexpr int N_BBAR = 256;
  constexpr int N_ROPE = 6;
  constexpr int E0 = N_ADA, E1 = E0 + N_WIN, E2 = E1 + N_WOUT, E3 = E2 + N_WQ, E4 = E3 + N_WUQ, E5 = E4 + N_WUKV,
                E6 = E5 + N_WGLU, E7 = E6 + N_SUBK, E8 = E7 + N_APOW, E9 = E8 + N_BBAR, E10 = E9 + N_ROPE;
  for (int item = bidx(); item < E10; item += gridDim.x) {
    if (item < E0) {
      const int l = item / 96, cb = item % 96;
      float* sl = (float*)smem;
      float* red = (float*)(smem + 9 * 1024 * 4);
      __syncthreads();
      for (int i = tid; i < 9 * 1024; i += NT) {
        const int b = i >> 10, kk = i & 1023;
        const float v = (b < 8) ? kp->in[I_C][b * 1024 + kk] : kp->in[I_CCTX][kk];
        sl[i] = v / (1.0f + __expf(-v));
      }
      __syncthreads();
      const int kq = tid >> 6, cl = tid & 63;
      const int n = cb * 64 + cl;
      float acc[9];
#pragma unroll
      for (int b = 0; b < 9; ++b) acc[b] = 0.f;
      const float* w = kp->in[I_WADA] + (size_t)l * 1024 * 6144 + (size_t)(kq * 256) * 6144 + n;
#pragma unroll 16
      for (int kk = 0; kk < 256; ++kk) {
        const float wv = w[(size_t)kk * 6144];
#pragma unroll
        for (int b = 0; b < 9; ++b) acc[b] += sl[b * 1024 + kq * 256 + kk] * wv;
      }
#pragma unroll
      for (int b = 0; b < 9; ++b) red[(kq * 9 + b) * 64 + cl] = acc[b];
      __syncthreads();
      float* mod = (float*)(ws + OFF_MOD);
      for (int i = tid; i < 9 * 64; i += NT) {
        const int b = i >> 6, c2 = i & 63;
        const float v = red[(0 * 9 + b) * 64 + c2] + red[(1 * 9 + b) * 64 + c2] + red[(2 * 9 + b) * 64 + c2] + red[(3 * 9 + b) * 64 + c2];
        mod[(size_t)(l * 9 + b) * 6144 + cb * 64 + c2] = v + kp->in[I_BADA][l * 6144 + cb * 64 + c2];
      }
    } else if (item < E1) {
      const int it = item - E0, l = it / 480, r = it % 480, nt = r / 16, kt = r % 16;
      transpose_tile(kp->in[I_WIN] + (size_t)l * 1024 * 1888, 1024, 1888, (u16*)(ws + OFF_WINT) + (size_t)l * NWIN * 1024, kt, nt, 1, nullptr, smem, NWIN,
                     (signed char*)(ws + OFF_WIN8) + (size_t)l * NWIN * 1024, WQ8_SCALE);
    } else if (item < E2) {
      const int it = item - E1, l = it / 256, r = it % 256, nt = r / 16, kt = r % 16;
      transpose_tile(kp->in[I_WOUT] + (size_t)l * 1024 * 1024, 1024, 1024, (u16*)(ws + OFF_WOUTT) + (size_t)l * 1024 * 1024, kt, nt, 0,
                     kp->in[I_MIXG] + l * 1024, smem, 1024, (signed char*)(ws + OFF_WOUT8) + (size_t)l * 1024 * 1024, WQ8_SCALE);
    } else if (item < E3) {
      const int it = item - E2, l = it / 512, r = it % 512, nt = r / 16, kt = r % 16;
      transpose_tile(kp->in[I_PWQ] + (size_t)l * 1024 * 2048, 1024, 2048, (u16*)(ws + OFF_WQT) + (size_t)l * 2048 * 1024, kt, nt, 0, nullptr, smem, 2048,
                     (signed char*)(ws + OFF_WQ8) + (size_t)l * 2048 * 1024, WQ8_SCALE);
    } else if (item < E4) {
      const int it = item - E3, l = it / 18, r = it % 18, nt = r / 3, kt = r % 3;
      transpose_tile(kp->in[I_WUQ] + (size_t)l * 192 * 384, 192, 384, (u16*)(ws + OFF_WUQT) + (size_t)l * 384 * 192, kt, nt, 0,
                     kp->in[I_QNG] + l * 192, smem);
    } else if (item < E5) {
      const int it = item - E4, l = it / 16, r = it % 16, nt = r / 2, kt = r % 2;
      transpose_tile(kp->in[I_WUKV] + (size_t)l * 128 * 512, 128, 512, (u16*)(ws + OFF_WUKVT) + (size_t)l * 512 * 128, kt, nt, 0,
                     kp->in[I_KVNG] + l * 128, smem);
    } else if (item < E6) {
      const int it = item - E5, l = it / 32, r = it % 32, nt = r / 4, kt = r % 4;
      transpose_tile(kp->in[I_WGLU] + (size_t)l * 256 * 512, 256, 512, (u16*)(ws + OFF_WGLUT) + (size_t)l * 512 * 256, kt, nt, 2, nullptr, smem);
    } else if (item < E7) {
      const int e = (item - E6) * NT + tid;
      ((u16*)(ws + OFF_SUBK))[e] = f2bf(kp->in[I_SUBK][e]);
    } else if (item < E8) {
      const int e = (item - E7) * NT + tid;
      const int m = e % 65, idx4 = e / 65;
      const float lr = kp->in[I_LRE][idx4], li = kp->in[I_LIM][idx4];
      const float step = __expf(kp->in[I_LSTEP][idx4 >> 6]);
      ((float2*)(ws + OFF_APOW))[e] = apow_calc(lr, li, step, m);
    } else if (item < E9) {
      const int e = (item - E8) * NT + tid;
      const int idx4 = e >> 4;
      const float lr = kp->in[I_LRE][idx4], li = kp->in[I_LIM][idx4];
      const float step = __expf(kp->in[I_LSTEP][idx4 >> 6]);
      const float2 ab = apow_calc(lr, li, step, 1);
      const float nr = ab.x - 1.0f, ni = ab.y;
      const float den = lr * lr + li * li;
      const float fr = (nr * lr + ni * li) / den, fi = (ni * lr - nr * li) / den;
      const float br = kp->in[I_BRE][e], bi = kp->in[I_BIM][e];
      ((float2*)(ws + OFF_BBAR))[e] = make_float2(fr * br - fi * bi, fr * bi + fi * br);
    } else {
      const int e = (item - E9) * NT + tid;
      if (e < 1024) {
        const int pos = e >> 4, i = e & 15;
        const float invf = __builtin_amdgcn_exp2f(-(float)i * (13.287712379549449f / 16.0f));
        const float rev = (float)pos * invf * 0.15915494309189535f;
        ((float2*)(ws + OFF_ROPE16))[e] = make_float2(__builtin_amdgcn_cosf(rev), __builtin_amdgcn_sinf(rev));
      } else if (e < 1536) {
        const int q = e - 1024, pos = q >> 3, i = q & 7;
        const float invf = __builtin_amdgcn_exp2f(-(float)i * (13.287712379549449f / 8.0f));
        const float rev = (float)pos * invf * 0.15915494309189535f;
        ((float2*)(ws + OFF_ROPE8))[q] = make_float2(__builtin_amdgcn_cosf(rev), __builtin_amdgcn_sinf(rev));
      }
    }
  }
}

__device__ __forceinline__ void s5_tables(KP kp) {
  unsigned char* ws = kp->ws;
  const int gtid = bidx() * NT + tidx(), gn = gridDim.x * NT;
  const float2* apow = (const float2*)(ws + OFF_APOW);
  const float2* bbar = (const float2*)(ws + OFF_BBAR);
  {
    float* ktab = (float*)(ws + OFF_KTAB);
    for (int e = gtid; e < 2 * 16 * 2 * 64 * 16; e += gn) {
      const int cp = e & 15, m = (e >> 4) & 63, dir = (e >> 10) & 1, g = (e >> 11) & 15, l = e >> 15;
      const int base4 = ((l * 2 + dir) * 16 + g) * 64;
      const int cbase = (((l * 2 + dir) * 16 + g) * 16 + cp) * 64;
      float acc[16];
#pragma unroll
      for (int q = 0; q < 16; ++q) acc[q] = 0.f;
      for (int pp = 0; pp < 64; ++pp) {
        const float2 C = make_float2(kp->in[I_CRE][cbase + pp], kp->in[I_CIM][cbase + pp]);
        const float2 ca = cmul(C, apow[(size_t)(base4 + pp) * 65 + m]);
        const f32x4* bb = (const f32x4*)(bbar + (size_t)(base4 + pp) * 16);
#pragma unroll
        for (int q = 0; q < 8; ++q) {
          const f32x4 b2 = bb[q];
          acc[2 * q] += ca.x * b2[0] - ca.y * b2[1];
          acc[2 * q + 1] += ca.x * b2[2] - ca.y * b2[3];
        }
      }
      f32x4* dst = (f32x4*)(ktab + (size_t)e * 16);
#pragma unroll
      for (int q = 0; q < 4; ++q) { f32x4 o; o[0] = acc[4 * q]; o[1] = acc[4 * q + 1]; o[2] = acc[4 * q + 2]; o[3] = acc[4 * q + 3]; dst[q] = o; }
    }
  }
  {
    u16* w1 = (u16*)(ws + OFF_W1);
    for (int e = gtid; e < 2 * 2 * 16 * 128 * 128; e += gn) {
      const int k0 = (e & 127) * 8, n = (e >> 7) & 127, ldg = e >> 14;
      const int dir = (ldg >> 4) & 1;
      const int pp = n >> 1, ri = n & 1, s = k0 >> 4, ch0 = k0 & 15;
      const int pw = dir ? s : 63 - s;
      const int idx4 = ldg * 64 + pp;
      const float2 a = apow[(size_t)idx4 * 65 + pw];
      const f32x4* bb = (const f32x4*)(bbar + (size_t)idx4 * 16 + ch0);
      float v[8];
#pragma unroll
      for (int q = 0; q < 4; ++q) {
        const f32x4 b2 = bb[q];
        v[2 * q] = ri ? (a.x * b2[1] + a.y * b2[0]) : (a.x * b2[0] - a.y * b2[1]);
        v[2 * q + 1] = ri ? (a.x * b2[3] + a.y * b2[2]) : (a.x * b2[2] - a.y * b2[3]);
      }
      u32x4 pk; pk[0] = pack2(v[0], v[1]); pk[1] = pack2(v[2], v[3]); pk[2] = pack2(v[4], v[5]); pk[3] = pack2(v[6], v[7]);
      *(u32x4*)(w1 + (size_t)e * 8) = pk;
    }
  }
}

constexpr size_t OFF_TT = OFF_M3;
constexpr size_t OFF_ST = OFF_M3 + al256((size_t)16 * 127 * 256 * 2);
__device__ __forceinline__ void m3_expand(KP kp, int layer) {
  unsigned char* ws = kp->ws;
  const int gtid = bidx() * NT + tidx(), gn = gridDim.x * NT;
  const float* ktab = (const float*)(ws + OFF_KTAB) + (size_t)layer * (16 * 2 * 64 * 256);
  const float2* apow = (const float2*)(ws + OFF_APOW);
  u16* tt = (u16*)(ws + OFF_TT);
  u16* st = (u16*)(ws + OFF_ST);
  for (int e = gtid; e < 16 * 127 * 32; e += gn) {
    const int ch0 = (e & 1) * 8, cp = (e >> 1) & 15, d = (e >> 5) % 127, g = (e >> 5) / 127;
    const int m = d - 63;
    float vals[8];
    if (m != 0) {
      const int dir = (m > 0) ? 0 : 1, am = (m > 0) ? m : -m;
      const float* src = ktab + ((((size_t)g * 2 + dir) * 64 + am) * 16 + cp) * 16 + ch0;
#pragma unroll
      for (int q = 0; q < 8; ++q) vals[q] = src[q];
    } else {
      const float* s0 = ktab + ((((size_t)g * 2 + 0) * 64 + 0) * 16 + cp) * 16 + ch0;
      const float* s1 = ktab + ((((size_t)g * 2 + 1) * 64 + 0) * 16 + cp) * 16 + ch0;
      const float dsk = kp->in[I_S5D][layer * 256 + g * 16 + cp];
#pragma unroll
      for (int q = 0; q < 8; ++q) vals[q] = s0[q] + s1[q] + ((ch0 + q == cp) ? dsk : 0.f);
    }
    u32x4 pk;
    pk[0] = pack2(vals[0], vals[1]); pk[1] = pack2(vals[2], vals[3]); pk[2] = pack2(vals[4], vals[5]); pk[3] = pack2(vals[6], vals[7]);
    *(u32x4*)(tt + (((size_t)g * 127 + d) * 16 + cp) * 16 + ch0) = pk;
  }
  for (int e = gtid; e < 16 * 1024 * 32; e += gn) {
    const int kq = e & 31, n = (e >> 5) & 1023, g = e >> 15;
    const int j = n >> 4, cp = n & 15;
    const int kk = kq * 8;
    const int dir = kk >> 7, p0 = (kk & 127) >> 1;
    const int pw = dir ? (64 - j) : (j + 1);
    const int ldg = (layer * 2 + dir) * 16 + g;
    float vals[8];
#pragma unroll
    for (int q = 0; q < 4; ++q) {
      const int pp = p0 + q;
      const int ci = (ldg * 16 + cp) * 64 + pp;
      const float2 C = make_float2(kp->in[I_CRE][ci], kp->in[I_CIM][ci]);
      const float2 z = cmul(C, apow[(size_t)(ldg * 64 + pp) * 65 + pw]);
      vals[2 * q] = z.x; vals[2 * q + 1] = -z.y;
    }
    u32x4 pk;
    pk[0] = pack2(vals[0], vals[1]); pk[1] = pack2(vals[2], vals[3]); pk[2] = pack2(vals[4], vals[5]); pk[3] = pack2(vals[6], vals[7]);
    *(u32x4*)(st + ((size_t)g * 1024 + n) * 256 + kk) = pk;
  }
}

template <bool KBLK = false, bool Q8 = false>
__device__ __forceinline__ void norm_mod_rows(const float* __restrict__ src_lat, const float* __restrict__ src_ctx, const float* __restrict__ g,
                              const float* __restrict__ modl, int sh_off, int sc_off, u16* __restrict__ dst, int nrows,
                              unsigned char* __restrict__ dst8 = nullptr, float* __restrict__ dscale = nullptr) {
  const int lane = tidx() & 63;
  const int gw = (bidx() * NT + tidx()) >> 6, nw = (gridDim.x * NT) >> 6;
  for (int r0 = gw; r0 < nrows; r0 += 2 * nw) {
    f32x4 v[2][4];
    int rr[2];
#pragma unroll
    for (int u = 0; u < 2; ++u) {
      const int r = r0 + u * nw;
      rr[u] = (r < nrows) ? r : r0;
      const float* src = (rr[u] < NLAT) ? (src_lat + (size_t)rr[u] * 1024) : (src_ctx + (size_t)(rr[u] - NLAT) * 1024);
#pragma unroll
      for (int i = 0; i < 4; ++i) v[u][i] = *(const f32x4*)(src + i * 256 + lane * 4);
    }
#pragma unroll
    for (int u = 0; u < 2; ++u) {
      const int r = r0 + u * nw;
      if (r >= nrows) break;
      const int bb = (r < NLAT) ? (r >> 12) : 8;
      float ss = 0.f;
#pragma unroll
      for (int i = 0; i < 4; ++i) ss += v[u][i][0] * v[u][i][0] + v[u][i][1] * v[u][i][1] + v[u][i][2] * v[u][i][2] + v[u][i][3] * v[u][i][3];
      ss = wave_sum(ss);
      const float rstd = rsqrtf(ss * (1.0f / 1024.0f) + EPSN);
      const float* mrow = modl + (size_t)bb * 6144;
      float oo[4][4];
      float amax = 0.f;
#pragma unroll
      for (int i = 0; i < 4; ++i) {
        const int c = i * 256 + lane * 4;
        const f32x4 gg = *(const f32x4*)(g + c);
        const f32x4 sh = *(const f32x4*)(mrow + sh_off + c);
        const f32x4 sc = *(const f32x4*)(mrow + sc_off + c);
#pragma unroll
        for (int j = 0; j < 4; ++j) { oo[i][j] = v[u][i][j] * rstd * gg[j] * (1.0f + sc[j]) + sh[j]; amax = fmaxf(amax, fabsf(oo[i][j])); }
        u32x2 pk; pk[0] = pack2(oo[i][0], oo[i][1]); pk[1] = pack2(oo[i][2], oo[i][3]);
        if (Q8) {}
        else if (KBLK) *(u32x2*)(dst + ((size_t)(c >> 5) * MTOT + r) * 32 + (c & 31)) = pk;
        else *(u32x2*)(dst + (size_t)r * 1024 + c) = pk;
      }
      if (Q8) {
#pragma unroll
        for (int o = 32; o >= 1; o >>= 1) amax = fmaxf(amax, __shfl_xor(amax, o));
        amax = fmaxf(amax, 1e-20f);
        const float qs = 127.0f / amax;
        if (lane == 0) dscale[r] = amax * (1.0f / 127.0f);
#pragma unroll
        for (int i = 0; i < 4; ++i) {
          const int c = i * 256 + lane * 4;
          unsigned w = 0;
#pragma unroll
          for (int j = 0; j < 4; ++j) w |= ((unsigned)((int)rintf(oo[i][j] * qs)) & 0xffu) << (8 * j);
          *(unsigned*)(dst8 + ((size_t)(c >> 5) * MTOT + r) * 32 + (c & 31)) = w;
        }
      }
    }
  }
}

__device__ __forceinline__ void phase1(KP kp, int layer) {
  unsigned char* ws = kp->ws;
  const int gtid = bidx() * NT + tidx(), gn = gridDim.x * NT;
  {
    const f32x4* su = (const f32x4*)(kp->in[I_PU] + (size_t)layer * 16384 * 1024);
    const f32x4* sv = (const f32x4*)(kp->in[I_PV] + (size_t)layer * 16384 * 1024);
    u32x4* du = (u32x4*)(ws + OFF_UB);
    u32x4* dv = (u32x4*)(ws + OFF_VB);
    for (int e = gtid; e < 16384 * 32; e += gn) {
      u32x4 pu, pv;
#pragma unroll
      for (int q = 0; q < 4; ++q) {
        const f32x4 a0 = su[(size_t)e * 8 + 2 * q], a1 = su[(size_t)e * 8 + 2 * q + 1];
        const size_t vb0 = (size_t)(e >> 5) * 256 + (size_t)(((e & 31) >> 3) * 64 + (e & 7));
        const f32x4 b0 = sv[vb0 + (2 * q) * 8], b1 = sv[vb0 + (2 * q + 1) * 8];
        unsigned wu = 0, wv = 0;
#pragma unroll
        for (int b = 0; b < 4; ++b) {
          const int k0 = (int)rintf(fminf(fmaxf(a0[b] * (64.0f * 7.0f / 6.0f), -7.0f), 7.0f)) + 8;
          const int k1 = (int)rintf(fminf(fmaxf(a1[b] * (64.0f * 7.0f / 6.0f), -7.0f), 7.0f)) + 8;
          wu |= (unsigned)(k0 | (k1 << 4)) << (8 * b);
        }
        wv = __builtin_amdgcn_cvt_scalef32_pk_fp4_f32(wv, b0[0] * 2.0f, b0[1] * 2.0f, 1.0f, 0);
        wv = __builtin_amdgcn_cvt_scalef32_pk_fp4_f32(wv, b0[2] * 2.0f, b0[3] * 2.0f, 1.0f, 1);
        wv = __builtin_amdgcn_cvt_scalef32_pk_fp4_f32(wv, b1[0] * 2.0f, b1[1] * 2.0f, 1.0f, 2);
        wv = __builtin_amdgcn_cvt_scalef32_pk_fp4_f32(wv, b1[2] * 2.0f, b1[3] * 2.0f, 1.0f, 3);
        pu[q] = wu; pv[q] = wv;
      }
      du[e] = pu; dv[e] = pv;
    }
  }
  if (layer == 0) s5_tables(kp);
  const float* src_lat = (layer == 0) ? kp->in[I_X] : kp->out;
  const float* src_ctx = (layer == 0) ? kp->in[I_CTX] : (const float*)(ws + OFF_XC);
  norm_mod_rows<true, true>(src_lat, src_ctx, kp->in[I_N1G] + layer * 1024, (const float*)(ws + OFF_MOD) + (size_t)layer * 9 * 6144, 0, 1024,
                (u16*)(ws + OFF_H), MTOT, ws + OFF_H8A, (float*)(ws + OFF_TS1));
}

template <class Epi>
__device__ __forceinline__ void gemm128(const u16* __restrict__ A, int lda, const u16* __restrict__ BT, int ldb, int K, int m0, int n0,
                                        unsigned char* smem, Epi& epi) {
  const int tid = tidx(), lane = tid & 63, wave = tid >> 6, wm = wave >> 1, wn = wave & 1;
  u16* sA = (u16*)smem;
  u16* sB = (u16*)(smem + 16384);
  f32x4 acc[4][4];
#pragma unroll
  for (int i = 0; i < 4; ++i)
#pragma unroll
    for (int j = 0; j < 4; ++j) acc[i][j] = (f32x4){0.f, 0.f, 0.f, 0.f};
  u32x4 ra[4], rb[4];
  const int lrow = tid >> 3, lc = tid & 7;
  const u16* ga = A + (size_t)(m0 + lrow) * lda + lc * 8;
  const u16* gb = BT + (size_t)(n0 + lrow) * ldb + lc * 8;
#pragma unroll
  for (int i = 0; i < 4; ++i) {
    ra[i] = *(const u32x4*)(ga + (size_t)(32 * i) * lda);
    rb[i] = *(const u32x4*)(gb + (size_t)(32 * i) * ldb);
  }
  for (int k0 = 0; k0 < K; k0 += 64) {
    __syncthreads();
#pragma unroll
    for (int i = 0; i < 4; ++i) {
      const int row = lrow + 32 * i;
      const int off = row * 64 + ((lc ^ (row & 7)) * 8);
      *(u32x4*)(sA + off) = ra[i];
      *(u32x4*)(sB + off) = rb[i];
    }
    __syncthreads();
    if (k0 + 64 < K) {
#pragma unroll
      for (int i = 0; i < 4; ++i) {
        ra[i] = *(const u32x4*)(ga + (size_t)(32 * i) * lda + k0 + 64);
        rb[i] = *(const u32x4*)(gb + (size_t)(32 * i) * ldb + k0 + 64);
      }
    }
#pragma unroll
    for (int ks = 0; ks < 2; ++ks) {
      bf16x8 af[4], bfr[4];
      const int c = ks * 4 + (lane >> 4);
#pragma unroll
      for (int mi = 0; mi < 4; ++mi) {
        const int row = wm * 64 + mi * 16 + (lane & 15);
        af[mi] = *(const bf16x8*)(sA + row * 64 + ((c ^ (row & 7)) * 8));
      }
#pragma unroll
      for (int ni = 0; ni < 4; ++ni) {
        const int row = wn * 64 + ni * 16 + (lane & 15);
        bfr[ni] = *(const bf16x8*)(sB + row * 64 + ((c ^ (row & 7)) * 8));
      }
#pragma unroll
      for (int mi = 0; mi < 4; ++mi)
#pragma unroll
        for (int ni = 0; ni < 4; ++ni) acc[mi][ni] = mfma16(af[mi], bfr[ni], acc[mi][ni]);
    }
  }
  epi(m0 + wm * 64, n0 + wn * 64, acc, lane);
}

template <int BK, class AL, class BL, class Epi>
__device__ __forceinline__ void gemm_t(AL al, BL bl, int K, int row0_out, int col0_out, unsigned char* smem, Epi& epi) {
  constexpr int CH = BK / 8;
  constexpr int NL = CH / 2;
  const int tid = tidx(), lane = tid & 63, wave = tid >> 6, wm = wave >> 1, wn = wave & 1;
  u16* sA = (u16*)smem;
  u16* sB = (u16*)(smem + 128 * BK * 2);
  f32x4 acc[4][4];
#pragma unroll
  for (int i = 0; i < 4; ++i)
#pragma unroll
    for (int j = 0; j < 4; ++j) acc[i][j] = (f32x4){0.f, 0.f, 0.f, 0.f};
  u32x4 ra[NL], rb[NL];
  const int lrow = tid / CH, lc = tid % CH;
  constexpr int RSTEP = 256 / CH;
#pragma unroll
  for (int i = 0; i < NL; ++i) {
    ra[i] = *(const u32x4*)al(lrow + RSTEP * i, lc * 8);
    rb[i] = *(const u32x4*)bl(lrow + RSTEP * i, lc * 8);
  }
  for (int k0 = 0; k0 < K; k0 += BK) {
    __syncthreads();
#pragma unroll
    for (int i = 0; i < NL; ++i) {
      const int row = lrow + RSTEP * i;
      const int off = row * BK + ((lc ^ (row & (CH - 1))) * 8);
      *(u32x4*)(sA + off) = ra[i];
      *(u32x4*)(sB + off) = rb[i];
    }
    __syncthreads();
    if (k0 + BK < K) {
#pragma unroll
      for (int i = 0; i < NL; ++i) {
        ra[i] = *(const u32x4*)al(lrow + RSTEP * i, k0 + BK + lc * 8);
        rb[i] = *(const u32x4*)bl(lrow + RSTEP * i, k0 + BK + lc * 8);
      }
    }
#pragma unroll
    for (int ks = 0; ks < BK / 32; ++ks) {
      bf16x8 af[4], bfr[4];
      const int c = ks * 4 + (lane >> 4);
#pragma unroll
      for (int mi = 0; mi < 4; ++mi) {
        const int row = wm * 64 + mi * 16 + (lane & 15);
        af[mi] = *(const bf16x8*)(sA + row * BK + ((c ^ (row & (CH - 1))) * 8));
      }
#pragma unroll
      for (int ni = 0; ni < 4; ++ni) {
        const int row = wn * 64 + ni * 16 + (lane & 15);
        bfr[ni] = *(const bf16x8*)(sB + row * BK + ((c ^ (row & (CH - 1))) * 8));
      }
#pragma unroll
      for (int mi = 0; mi < 4; ++mi)
#pragma unroll
        for (int ni = 0; ni < 4; ++ni) acc[mi][ni] = mfma16(af[mi], bfr[ni], acc[mi][ni]);
    }
  }
  epi(row0_out + wm * 64, col0_out + wn * 64, acc, lane);
}
template <bool SWAP = false, class AL, class BL, class Epi>
__device__ __forceinline__ void gemm_dma(AL al, BL bl, int K, int row0_out, int col0_out, unsigned char* smem, Epi& epi,
                                         bool prefetched, bool has_next, AL nal, BL nbl) {
  constexpr int BK = 64, CH = 8;
  const int tid = tidx(), lane = tid & 63, wave = tid >> 6, wm = wave >> 1, wn = wave & 1;
  f32x4 acc[4][4];
#pragma unroll
  for (int i = 0; i < 4; ++i)
#pragma unroll
    for (int j = 0; j < 4; ++j) acc[i][j] = (f32x4){0.f, 0.f, 0.f, 0.f};
  const int lrow = tid >> 3, lc = tid & 7;
  auto stage = [&](int buf, int k0) {
    unsigned char* sa = smem + buf * 32768;
    unsigned char* sb = sa + 16384;
#pragma unroll
    for (int i = 0; i < 4; ++i) {
      const int row = lrow + 32 * i;
      const int csrc = (lc ^ (row & 7)) * 8;
      __builtin_amdgcn_global_load_lds((const unsigned*)al(row, k0 + csrc), (__attribute__((address_space(3))) unsigned*)(sa + (tid + 256 * i) * 16), 16, 0, 0);
      __builtin_amdgcn_global_load_lds((const unsigned*)bl(row, k0 + csrc), (__attribute__((address_space(3))) unsigned*)(sb + (tid + 256 * i) * 16), 16, 0, 0);
    }
  };
  auto stage_next = [&]() {
    unsigned char* sa = smem;
    unsigned char* sb = sa + 16384;
#pragma unroll
    for (int i = 0; i < 4; ++i) {
      const int row = lrow + 32 * i;
      const int csrc = (lc ^ (row & 7)) * 8;
      __builtin_amdgcn_global_load_lds((const unsigned*)nal(row, csrc), (__attribute__((address_space(3))) unsigned*)(sa + (tid + 256 * i) * 16), 16, 0, 0);
      __builtin_amdgcn_global_load_lds((const unsigned*)nbl(row, csrc), (__attribute__((address_space(3))) unsigned*)(sb + (tid + 256 * i) * 16), 16, 0, 0);
    }
  };
  const int nt = K / BK;
  if (!prefetched) {
    __syncthreads();
    stage(0, 0);
  }
  for (int t = 0; t < nt; ++t) {
    asm volatile("s_waitcnt vmcnt(0)" ::: "memory");
    __syncthreads();
    if (t + 1 < nt) stage((t + 1) & 1, (t + 1) * BK);
    else if (has_next && (nt & 1) == 0) stage_next();
    const u16* sA = (const u16*)(smem + (t & 1) * 32768);
    const u16* sB = sA + 8192;
#pragma unroll
    for (int ks = 0; ks < 2; ++ks) {
      bf16x8 af[4], bfr[4];
      const int c = ks * 4 + (lane >> 4);
#pragma unroll
      for (int mi = 0; mi < 4; ++mi) {
        const int row = wm * 64 + mi * 16 + (lane & 15);
        af[mi] = *(const bf16x8*)(sA + row * BK + ((c ^ (row & (CH - 1))) * 8));
      }
#pragma unroll
      for (int ni = 0; ni < 4; ++ni) {
        const int row = wn * 64 + ni * 16 + (lane & 15);
        bfr[ni] = *(const bf16x8*)(sB + row * BK + ((c ^ (row & (CH - 1))) * 8));
      }
#pragma unroll
      for (int mi = 0; mi < 4; ++mi)
#pragma unroll
        for (int ni = 0; ni < 4; ++ni) acc[mi][ni] = SWAP ? mfma16(bfr[ni], af[mi], acc[mi][ni]) : mfma16(af[mi], bfr[ni], acc[mi][ni]);
    }
  }
  epi(row0_out + wm * 64, col0_out + wn * 64, acc, lane);
}
template <bool SWAP = false, class AL, class BL, class Epi>
__device__ __forceinline__ void gemm_dma(AL al, BL bl, int K, int row0_out, int col0_out, unsigned char* smem, Epi& epi) {
  gemm_dma<SWAP>(al, bl, K, row0_out, col0_out, smem, epi, false, false, al, bl);
}
template <bool SWAP = false, class AL, class BL, class Epi>
__device__ __forceinline__ void gemm_dma3(AL al, BL bl, int K, int row0_out, int col0_out, unsigned char* smem, Epi& epi) {
  constexpr int BK = 32, STG = 24576;
  const int tid = tidx(), lane = tid & 63, wave = tid >> 6, wm = wave >> 1, wn = wave & 1;
  f32x4 acc[2][4][4];
#pragma unroll
  for (int h = 0; h < 2; ++h)
#pragma unroll
    for (int i = 0; i < 4; ++i)
#pragma unroll
      for (int j = 0; j < 4; ++j) acc[h][i][j] = (f32x4){0.f, 0.f, 0.f, 0.f};
  const int lrow = tid >> 2, lc = tid & 3;
  auto stage = [&](int buf, int k0) {
    unsigned char* sa = smem + buf * STG;
    unsigned char* sb = sa + 16384;
#pragma unroll
    for (int i = 0; i < 4; ++i) {
      const int row = lrow + 64 * i;
      const int csrc = (lc ^ ((row >> 2) & 3)) * 8;
      __builtin_amdgcn_global_load_lds((const unsigned*)al(row, k0 + csrc), (__attribute__((address_space(3))) unsigned*)(sa + (tid + 256 * i) * 16), 16, 0, 0);
    }
#pragma unroll
    for (int i = 0; i < 2; ++i) {
      const int row = lrow + 64 * i;
      const int csrc = (lc ^ ((row >> 2) & 3)) * 8;
      __builtin_amdgcn_global_load_lds((const unsigned*)bl(row, k0 + csrc), (__attribute__((address_space(3))) unsigned*)(sb + (tid + 256 * i) * 16), 16, 0, 0);
    }
  };
  const int nt = K / BK;
  asm volatile("s_waitcnt vmcnt(0)" ::: "memory");
  __syncthreads();
  stage(0, 0);
  stage(1, BK);
  int buf = 0;
  for (int t = 0; t < nt; ++t) {
    if (t + 1 < nt) asm volatile("s_waitcnt vmcnt(6)" ::: "memory");
    else asm volatile("s_waitcnt vmcnt(0)" ::: "memory");
    __builtin_amdgcn_s_barrier();
    asm volatile("" ::: "memory");
    const u16* sA = (const u16*)(smem + buf * STG);
    const u16* sB = sA + 8192;
    const int c = lane >> 4;
    bf16x8 af[8], bfr[4];
#pragma unroll
    for (int ni = 0; ni < 4; ++ni) {
      const int row = wn * 64 + ni * 16 + (lane & 15);
      bfr[ni] = *(const bf16x8*)(sB + row * BK + ((c ^ ((row >> 2) & 3)) * 8));
    }
#pragma unroll
    for (int mi = 0; mi < 8; ++mi) {
      const int row = wm * 128 + mi * 16 + (lane & 15);
      af[mi] = *(const bf16x8*)(sA + row * BK + ((c ^ ((row >> 2) & 3)) * 8));
    }
    __builtin_amdgcn_sched_barrier(0);
    if (t + 2 < nt) stage((buf >= 1) ? buf - 1 : 2, (t + 2) * BK);
    __builtin_amdgcn_sched_barrier(0);
#pragma unroll
    for (int mi = 0; mi < 8; ++mi) {
#pragma unroll
      for (int ni = 0; ni < 4; ++ni)
        acc[mi >> 2][mi & 3][ni] = SWAP ? mfma16(bfr[ni], af[mi], acc[mi >> 2][mi & 3][ni]) : mfma16(af[mi], bfr[ni], acc[mi >> 2][mi & 3][ni]);
      __builtin_amdgcn_sched_barrier(0);
    }
    buf = (buf == 2) ? 0 : buf + 1;
  }
  epi(row0_out + wm * 128, col0_out + wn * 64, acc[0], lane);
  epi(row0_out + wm * 128 + 64, col0_out + wn * 64, acc[1], lane);
}
struct LoadKB {
  const u16* base; int nrows;
  __device__ __forceinline__ const u16* operator()(int r, int k) const { return base + ((size_t)(k >> 5) * nrows + r) * 32 + (k & 31); }
};
typedef __attribute__((ext_vector_type(4))) int i32x4;
template <bool SWAP = false, int MH = 2, class AL, class BL, class Epi>
__device__ __forceinline__ void gemm_dma3_i8(AL al, BL bl, int K, int row0_out, int col0_out, unsigned char* smem, Epi& epi) {
  constexpr int BKB = 64, STG = 24576;
  const int tid = tidx(), lane = tid & 63, wave = tid >> 6, wm = wave >> 1, wn = wave & 1;
  i32x4 acc[MH][4][4];
#pragma unroll
  for (int h = 0; h < MH; ++h)
#pragma unroll
    for (int i = 0; i < 4; ++i)
#pragma unroll
      for (int j = 0; j < 4; ++j) acc[h][i][j] = (i32x4){0, 0, 0, 0};
  const int lrow = tid >> 2, lc = tid & 3;
  auto stage = [&](int buf, int k0) {
    unsigned char* sa = smem + buf * STG;
    unsigned char* sb = sa + 16384;
#pragma unroll
    for (int i = 0; i < 2 * MH; ++i) {
      const int row = lrow + 64 * i;
      const int csrc = (lc ^ ((row >> 2) & 3)) * 16;
      __builtin_amdgcn_global_load_lds((const unsigned*)al(row, k0 + csrc), (__attribute__((address_space(3))) unsigned*)(sa + (tid + 256 * i) * 16), 16, 0, 0);
    }
#pragma unroll
    for (int i = 0; i < 2; ++i) {
      const int row = lrow + 64 * i;
      const int csrc = (lc ^ ((row >> 2) & 3)) * 16;
      __builtin_amdgcn_global_load_lds((const unsigned*)bl(row, k0 + csrc), (__attribute__((address_space(3))) unsigned*)(sb + (tid + 256 * i) * 16), 16, 0, 0);
    }
  };
  const int nt = K / BKB;
  asm volatile("s_waitcnt vmcnt(0)" ::: "memory");
  __syncthreads();
  stage(0, 0);
  stage(1, BKB);
  int buf = 0;
  for (int t = 0; t < nt; ++t) {
    if (t + 1 < nt) { if (MH == 2) asm volatile("s_waitcnt vmcnt(6)" ::: "memory"); else asm volatile("s_waitcnt vmcnt(4)" ::: "memory"); }
    else asm volatile("s_waitcnt vmcnt(0)" ::: "memory");
    __builtin_amdgcn_s_barrier();
    asm volatile("" ::: "memory");
    const unsigned char* sA = smem + buf * STG;
    const unsigned char* sB = sA + 16384;
    const int c = lane >> 4;
    i32x4 af[4 * MH], bfr[4];
#pragma unroll
    for (int ni = 0; ni < 4; ++ni) {
      const int row = wn * 64 + ni * 16 + (lane & 15);
      bfr[ni] = *(const i32x4*)(sB + row * BKB + ((c ^ ((row >> 2) & 3)) * 16));
    }
#pragma unroll
    for (int mi = 0; mi < 4 * MH; ++mi) {
      const int row = wm * (64 * MH) + mi * 16 + (lane & 15);
      af[mi] = *(const i32x4*)(sA + row * BKB + ((c ^ ((row >> 2) & 3)) * 16));
    }
    __builtin_amdgcn_sched_barrier(0);
    if (t + 2 < nt) stage((buf >= 1) ? buf - 1 : 2, (t + 2) * BKB);
    __builtin_amdgcn_sched_barrier(0);
#pragma unroll
    for (int mi = 0; mi < 4 * MH; ++mi) {
#pragma unroll
      for (int ni = 0; ni < 4; ++ni)
        acc[mi >> 2][mi & 3][ni] = SWAP ? __builtin_amdgcn_mfma_i32_16x16x64_i8(bfr[ni], af[mi], acc[mi >> 2][mi & 3][ni], 0, 0, 0)
                                        : __builtin_amdgcn_mfma_i32_16x16x64_i8(af[mi], bfr[ni], acc[mi >> 2][mi & 3][ni], 0, 0, 0);
      __builtin_amdgcn_sched_barrier(0);
    }
    buf = (buf == 2) ? 0 : buf + 1;
  }
#pragma unroll
  for (int h = 0; h < MH; ++h) epi(row0_out + wm * (64 * MH) + 64 * h, col0_out + wn * 64, acc[h], lane);
}
struct LoadKB8 {
  const unsigned char* base; int nrows;
  __device__ __forceinline__ const unsigned char* operator()(int r, int k) const { return base + ((size_t)(k >> 5) * nrows + r) * 32 + (k & 31); }
};
template <bool SWAP, class E>
struct EpiI8 {
  const E& e; const float* ts; float sw;
  __device__ __forceinline__ void operator()(int row0, int col0, i32x4 (&acc)[4][4], int lane) const {
    f32x4 f[4][4];
#pragma unroll
    for (int mi = 0; mi < 4; ++mi) {
      if (SWAP) {
        const float s = ts[row0 + mi * 16 + (lane & 15)] * sw;
#pragma unroll
        for (int ni = 0; ni < 4; ++ni)
#pragma unroll
          for (int j = 0; j < 4; ++j) f[mi][ni][j] = (float)acc[mi][ni][j] * s;
      } else {
        const f32x4 s4 = *(const f32x4*)(ts + row0 + mi * 16 + (lane >> 4) * 4);
#pragma unroll
        for (int ni = 0; ni < 4; ++ni)
#pragma unroll
          for (int j = 0; j < 4; ++j) f[mi][ni][j] = (float)acc[mi][ni][j] * (s4[j] * sw);
      }
    }
    e(row0, col0, f, lane);
  }
};
struct LoadRows {
  const u16* base; int ld;
  __device__ __forceinline__ const u16* operator()(int r, int k) const { return base + (size_t)r * ld + k; }
};

__device__ __forceinline__ bool xcd_tile(int bid, int nblk, int round, int MT, int NTN, int& mt, int& nt) {
  const int x = bid & 7, per = nblk >> 3;
  int li = (bid >> 3) + per * round;
  const int mloc = MT >> 3;
  for (int g0 = 0; g0 < NTN; g0 += 8) {
    const int gw = (NTN - g0 < 8) ? (NTN - g0) : 8;
    const int size = mloc * gw;
    if (li < size) { mt = x * mloc + li / gw; nt = g0 + li % gw; return true; }
    li -= size;
  }
  return false;
}
struct EpiG1T {
  unsigned char* ws;
  __device__ __forceinline__ void operator()(int row0, int col0, f32x4 (&acc)[4][4], int lane) const {
    const float2* rope16 = (const float2*)(ws + OFF_ROPE16);
    const float2* rope8 = (const float2*)(ws + OFF_ROPE8);
    const bool is_lat = row0 < NLAT;
    const int cl = lane & 15, rq = lane >> 4;
#pragma unroll
    for (int mi = 0; mi < 4; ++mi) {
      const int r = row0 + mi * 16 + cl;
      int b, tk;
      row_btk(r, b, tk);
      if (col0 < 384 || (col0 >= 1152 && col0 < 1664)) {
        u16* base; int nh, head; float scale = 1.0f; bool rope = false;
        if (col0 < 256) { base = (u16*)(ws + OFF_QA); nh = 4; head = col0 >> 6; scale = 0.125f * LOG2E; rope = is_lat; }
        else if (col0 < 384) { base = (u16*)(ws + OFF_KA); nh = 2; head = (col0 - 256) >> 6; rope = is_lat; }
        else if (col0 < 1408) { base = (u16*)(ws + OFF_QD); nh = 4; head = (col0 - 1152) >> 6; scale = 0.125f * LOG2E; }
        else { base = (u16*)(ws + OFF_KD); nh = 4; head = (col0 - 1408) >> 6; }
        f32x4 v0 = acc[mi][0], v1 = acc[mi][1], v2 = acc[mi][2], v3 = acc[mi][3];
        if (rope) {
          const f32x4* cr = (const f32x4*)(rope16 + (tk >> 6) * 16 + rq * 4);
          const f32x4* cc = (const f32x4*)(rope16 + (tk & 63) * 16 + rq * 4);
          const f32x4 r01 = cr[0], r23 = cr[1], c01 = cc[0], c23 = cc[1];
          const float rc[4] = {r01[0], r01[2], r23[0], r23[2]}, rs[4] = {r01[1], r01[3], r23[1], r23[3]};
          const float kc[4] = {c01[0], c01[2], c23[0], c23[2]}, ks[4] = {c01[1], c01[3], c23[1], c23[3]};
#pragma unroll
          for (int j = 0; j < 4; ++j) {
            const float a0 = v0[j] * rc[j] - v1[j] * rs[j], a1 = v0[j] * rs[j] + v1[j] * rc[j];
            const float a2 = v2[j] * kc[j] - v3[j] * ks[j], a3 = v2[j] * ks[j] + v3[j] * kc[j];
            v0[j] = a0; v1[j] = a1; v2[j] = a2; v3[j] = a3;
          }
        }
        u16* dst = base + ((size_t)(b * nh + head) * LK + tk) * 64 + rq * 4;
        u32x2 p0, p1, p2, p3;
        p0[0] = pack2(v0[0] * scale, v0[1] * scale); p0[1] = pack2(v0[2] * scale, v0[3] * scale);
        p1[0] = pack2(v1[0] * scale, v1[1] * scale); p1[1] = pack2(v1[2] * scale, v1[3] * scale);
        p2[0] = pack2(v2[0] * scale, v2[1] * scale); p2[1] = pack2(v2[2] * scale, v2[3] * scale);
        p3[0] = pack2(v3[0] * scale, v3[1] * scale); p3[1] = pack2(v3[2] * scale, v3[3] * scale);
        *(u32x2*)(dst) = p0; *(u32x2*)(dst + 16) = p1; *(u32x2*)(dst + 32) = p2; *(u32x2*)(dst + 48) = p3;
      } else if (col0 >= 832 && col0 < 896) {
#pragma unroll
        for (int ni = 0; ni < 2; ++ni) {
          f32x4 x = acc[mi][ni];
          f32x4 other;
#pragma unroll
          for (int j = 0; j < 4; ++j) other[j] = __shfl_xor(x[j], 32);
          if (is_lat) {
            const int pos = (ni == 0) ? (tk >> 6) : (tk & 63);
            const f32x4* cs = (const f32x4*)(rope8 + pos * 8 + (rq & 1) * 4);
            const f32x4 c01 = cs[0], c23 = cs[1];
            const float cc[4] = {c01[0], c01[2], c23[0], c23[2]}, ss[4] = {c01[1], c01[3], c23[1], c23[3]};
#pragma unroll
            for (int j = 0; j < 4; ++j) x[j] = (rq < 2) ? (x[j] * cc[j] - other[j] * ss[j]) : (other[j] * ss[j] + x[j] * cc[j]);
          }
          u32x2 pk; pk[0] = pack2(x[0], x[1]); pk[1] = pack2(x[2], x[3]);
#pragma unroll
          for (int h = 0; h < 4; ++h) *(u32x2*)((u16*)(ws + OFF_KB) + ((size_t)(b * 4 + h) * LK + tk) * 96 + 64 + ni * 16 + rq * 4) = pk;
        }
      } else {
        u16* base; int width, cofs;
        if (col0 < 704) { base = (u16*)(ws + OFF_CQ); width = 192; cofs = col0 - 512; }
        else if (col0 < 832) { base = (u16*)(ws + OFF_CKV); width = 128; cofs = col0 - 704; }
        else { base = (u16*)(ws + OFF_U5); width = 256; cofs = col0 - 896; }
#pragma unroll
        for (int ni = 0; ni < 4; ++ni) {
          u32x2 pk; pk[0] = pack2(acc[mi][ni][0], acc[mi][ni][1]); pk[1] = pack2(acc[mi][ni][2], acc[mi][ni][3]);
          *(u32x2*)(base + (size_t)r * width + cofs + ni * 16 + rq * 4) = pk;
        }
      }
    }
  }
};
struct EpiG1 {
  unsigned char* ws;
  __device__ __forceinline__ void operator()(int row0, int col0, f32x4 (&acc)[4][4], int lane) const {
    const float2* rope16 = (const float2*)(ws + OFF_ROPE16);
    const float2* rope8 = (const float2*)(ws + OFF_ROPE8);
    const bool is_lat = row0 < NLAT;
    const int cl = lane & 15, rq = lane >> 4;
#pragma unroll
    for (int mi = 0; mi < 4; ++mi) {
      const int r0 = row0 + mi * 16 + rq * 4;
      int b, tk0;
      row_btk(r0, b, tk0);
      if (col0 < 384 || (col0 >= 1152 && col0 < 1664)) {
        u16* base; int nh, head; float scale = 1.0f; bool rope = false;
        if (col0 < 256) { base = (u16*)(ws + OFF_QA); nh = 4; head = col0 >> 6; scale = 0.125f * LOG2E; rope = is_lat; }
        else if (col0 < 384) { base = (u16*)(ws + OFF_KA); nh = 2; head = (col0 - 256) >> 6; rope = is_lat; }
        else if (col0 < 1408) { base = (u16*)(ws + OFF_QD); nh = 4; head = (col0 - 1152) >> 6; scale = 0.125f * LOG2E; }
        else { base = (u16*)(ws + OFF_KD); nh = 4; head = (col0 - 1408) >> 6; }
#pragma unroll
        for (int j = 0; j < 4; ++j) {
          const int tk = tk0 + j;
          float v0 = acc[mi][0][j], v1 = acc[mi][1][j], v2 = acc[mi][2][j], v3 = acc[mi][3][j];
          if (rope) {
            const float2 cr = rope16[(tk >> 6) * 16 + cl];
            const float2 cc = rope16[(tk & 63) * 16 + cl];
            const float a0 = v0 * cr.x - v1 * cr.y, a1 = v0 * cr.y + v1 * cr.x;
            const float a2 = v2 * cc.x - v3 * cc.y, a3 = v2 * cc.y + v3 * cc.x;
            v0 = a0; v1 = a1; v2 = a2; v3 = a3;
          }
          u16* dst = base + ((size_t)(b * nh + head) * LK + tk) * 64 + cl;
          dst[0] = f2bf(v0 * scale); dst[16] = f2bf(v1 * scale); dst[32] = f2bf(v2 * scale); dst[48] = f2bf(v3 * scale);
        }
      } else if ((col0 >= 384 && col0 < 512) || col0 >= 1664) {
        u16* base; int nh, head;
        if (col0 < 512) { base = (u16*)(ws + OFF_VTA); nh = 2; head = (col0 - 384) >> 6; }
        else { base = (u16*)(ws + OFF_VTD); nh = 4; head = (col0 - 1664) >> 6; }
#pragma unroll
        for (int ni = 0; ni < 4; ++ni) {
          const int d = ni * 16 + cl;
          u32x2 pk; pk[0] = pack2(acc[mi][ni][0], acc[mi][ni][1]); pk[1] = pack2(acc[mi][ni][2], acc[mi][ni][3]);
          *(u32x2*)(base + ((size_t)(b * nh + head) * 64 + d) * LK + tk0) = pk;
        }
      } else if (col0 >= 832 && col0 < 896) {
#pragma unroll
        for (int ni = 0; ni < 2; ++ni) {
#pragma unroll
          for (int j = 0; j < 4; ++j) {
            const int tk = tk0 + j;
            float x = acc[mi][ni][j];
            const float other = __shfl_xor(x, 8);
            if (is_lat) {
              const int pos = (ni == 0) ? (tk >> 6) : (tk & 63);
              const float2 cs = rope8[pos * 8 + (cl & 7)];
              x = (cl < 8) ? (x * cs.x - other * cs.y) : (other * cs.y + x * cs.x);
            }
            const u16 hv = f2bf(x);
#pragma unroll
            for (int h = 0; h < 4; ++h) ((u16*)(ws + OFF_KB))[((size_t)(b * 4 + h) * LK + tk) * 96 + 64 + ni * 16 + cl] = hv;
          }
        }
      } else {
        u16* base; int width, cofs;
        if (col0 < 704) { base = (u16*)(ws + OFF_CQ); width = 192; cofs = col0 - 512; }
        else if (col0 < 832) { base = (u16*)(ws + OFF_CKV); width = 128; cofs = col0 - 704; }
        else { base = (u16*)(ws + OFF_U5); width = 256; cofs = col0 - 896; }
#pragma unroll
        for (int ni = 0; ni < 4; ++ni)
#pragma unroll
          for (int j = 0; j < 4; ++j) base[(size_t)(r0 + j) * width + cofs + ni * 16 + cl] = f2bf(acc[mi][ni][j]);
      }
    }
  }
};

__device__ __forceinline__ void phase2(KP kp, int layer, unsigned char* smem) {
  m3_expand(kp, layer);
  EpiG1 epi{kp->ws};
  EpiG1T epit{kp->ws};
  const u16* A = (const u16*)(kp->ws + OFF_H);
  const u16* BT = (const u16*)(kp->ws + OFF_WINT) + (size_t)layer * NWIN * 1024;
  constexpr int NTN = NWIN / 128;
  const int bid = bidx(), nblk = gridDim.x;
  {
    const int per = nblk >> 3;
    const int rem = ((NLAT / 256 / 8) * NTN) % per;
    const int j = (rem == 0) ? bid : (((bid >> 3) - rem) * 8 + (bid & 7));
    const int nj = (rem == 0) ? nblk : ((per - rem) * 8);
    int itc = j;
    for (int r = 0;; ++r) {
      int mt, nt;
      if (!xcd_tile(bid, nblk, r, NLAT / 256, NTN, mt, nt)) {
        if (itc < 0 || itc >= (NCTX / 256) * NTN) break;
        mt = NLAT / 256 + itc / NTN; nt = itc % NTN;
        itc += nj;
      }
      LoadKB8 al{(const unsigned char*)(kp->ws + OFF_H8A) + (size_t)mt * 256 * 32, MTOT};
      LoadKB8 bl{(const unsigned char*)(kp->ws + OFF_WIN8) + (size_t)layer * NWIN * 1024 + (size_t)nt * 128 * 32, NWIN};
      const float* ts1 = (const float*)(kp->ws + OFF_TS1);
      if (nt == 3 || nt >= 13) { EpiI8<false, EpiG1> e8{epi, ts1, 1.0f / WQ8_SCALE}; gemm_dma3_i8<false>(al, bl, 1024, mt * 256, nt * 128, smem, e8); }
      else { EpiI8<true, EpiG1T> e8{epit, ts1, 1.0f / WQ8_SCALE}; gemm_dma3_i8<true>(al, bl, 1024, mt * 256, nt * 128, smem, e8); }
    }
  }
}

template <int MI, int NI, class AF, class BF>
__device__ __forceinline__ void wave_mma(f32x4 (&acc)[MI][NI], int ksteps, AF af, BF bf) {
  for (int ks = 0; ks < ksteps; ++ks) {
    bf16x8 a[MI], b[NI];
#pragma unroll
    for (int mi = 0; mi < MI; ++mi) a[mi] = af(mi, ks);
#pragma unroll
    for (int ni = 0; ni < NI; ++ni) b[ni] = bf(ni, ks);
#pragma unroll
    for (int mi = 0; mi < MI; ++mi)
#pragma unroll
      for (int ni = 0; ni < NI; ++ni) acc[mi][ni] = mfma16(a[mi], b[ni], acc[mi][ni]);
  }
}
template <int MI, int NI>
__device__ __forceinline__ void zero_acc(f32x4 (&acc)[MI][NI]) {
#pragma unroll
  for (int i = 0; i < MI; ++i)
#pragma unroll
    for (int j = 0; j < NI; ++j) acc[i][j] = (f32x4){0.f, 0.f, 0.f, 0.f};
}

__device__ __forceinline__ int chunk_row0(int cidx) {
  const int b = cidx / 68, c = cidx % 68;
  return (c < 64) ? (b * 4096 + c * 64) : (NLAT + b * 256 + (c - 64) * 64);
}

struct EpiMlaQ {
  unsigned char* ws; const float* srs;
  int tile_row0;
  __device__ __forceinline__ void operator()(int row0, int col0, f32x4 (&acc)[4][4], int lane) const {
    const float2* rope8 = (const float2*)(ws + OFF_ROPE8);
    const int cl = lane & 15, rq = lane >> 4;
    const bool is_lat = row0 < NLAT;
#pragma unroll
    for (int mi = 0; mi < 4; ++mi) {
      const int r0 = row0 + mi * 16 + rq * 4;
      int b, tk0;
      row_btk(r0, b, tk0);
#pragma unroll
      for (int ni = 0; ni < 4; ++ni) {
        const int t16 = (col0 >> 4) + ni;
        const int head = t16 / 6, sub = t16 % 6;
#pragma unroll
        for (int j = 0; j < 4; ++j) {
          const int tk = tk0 + j;
          float x = acc[mi][ni][j] * srs[r0 + j - tile_row0];
          if (sub >= 4) {
            const float other = __shfl_xor(x, 8);
            if (is_lat) {
              const int pos = (sub == 4) ? (tk >> 6) : (tk & 63);
              const float2 cs = rope8[pos * 8 + (cl & 7)];
              x = (cl < 8) ? (x * cs.x - other * cs.y) : (other * cs.y + x * cs.x);
            }
          }
          ((u16*)(ws + OFF_QB))[((size_t)(b * 4 + head) * LK + tk) * 96 + sub * 16 + cl] = f2bf(x * (0.10206207261596575f * LOG2E));
        }
      }
    }
  }
};
struct EpiMlaKV {
  unsigned char* ws; const float* srs; int tile_row0;
  __device__ __forceinline__ void operator()(int row0, int col0, f32x4 (&acc)[4][4], int lane) const {
    const int cl = lane & 15, rq = lane >> 4;
    const int head = col0 >> 7;
    const bool isv = (col0 & 64) != 0;
#pragma unroll
    for (int mi = 0; mi < 4; ++mi) {
      const int r0 = row0 + mi * 16 + rq * 4;
      int b, tk0;
      row_btk(r0, b, tk0);
      float rs[4];
#pragma unroll
      for (int j = 0; j < 4; ++j) rs[j] = srs[r0 + j - tile_row0];
      if (!isv) {
#pragma unroll
        for (int ni = 0; ni < 4; ++ni)
#pragma unroll
          for (int j = 0; j < 4; ++j)
            ((u16*)(ws + OFF_KB))[((size_t)(b * 4 + head) * LK + tk0 + j) * 96 + ni * 16 + cl] = f2bf(acc[mi][ni][j] * rs[j]);
      } else {
#pragma unroll
        for (int ni = 0; ni < 4; ++ni) {
          u32x2 pk;
          pk[0] = pack2(acc[mi][ni][0] * rs[0], acc[mi][ni][1] * rs[1]);
          pk[1] = pack2(acc[mi][ni][2] * rs[2], acc[mi][ni][3] * rs[3]);
          *(u32x2*)((u16*)(ws + OFF_VTB) + ((size_t)(b * 4 + head) * 64 + ni * 16 + cl) * LK + tk0) = pk;
        }
      }
    }
  }
};
struct EpiS1 {
  float* S; int g, dir;
  __device__ __forceinline__ void operator()(int row0, int col0, f32x4 (&acc)[4][4], int lane) const {
    const int cl = lane & 15, rq = lane >> 4;
#pragma unroll
    for (int mi = 0; mi < 4; ++mi)
#pragma unroll
      for (int j = 0; j < 4; ++j) {
        const int cidx = row0 + mi * 16 + rq * 4 + j;
        if (cidx < 544) {
#pragma unroll
          for (int ni = 0; ni < 4; ++ni) S[(((size_t)cidx * 16 + g) * 2 + dir) * 128 + col0 + ni * 16 + cl] = acc[mi][ni][j];
        }
      }
  }
};
struct LoadS5A {
  const u16* U5; const u16* Hin; int g, m0;
  __device__ __forceinline__ const u16* operator()(int r, int k) const {
    int cidx = m0 + r; cidx = cidx < 544 ? cidx : 543;
    if (k < 1024) return U5 + (size_t)(chunk_row0(cidx) + (k >> 4)) * 256 + g * 16 + (k & 15);
    return Hin + ((size_t)cidx * 16 + g) * 256 + (k - 1024);
  }
};
__device__ __forceinline__ void phase3(KP kp, int layer, unsigned char* smem) {
  unsigned char* ws = kp->ws;
  const int tid = tidx();
  constexpr int MT = MTOT / 128;
  constexpr int N_Q = MT * 3, N_KV = MT * 4, N_S1 = 32 * 5;
  float* srs = (float*)(smem + 65536);
  for (int it = bidx(); it < N_Q + N_KV + N_S1; it += gridDim.x) {
    if (it < N_Q + N_KV) {
      const bool isq = it < N_Q;
      const int iq = isq ? it : it - N_Q;
      const int ntn = isq ? 3 : 4;
      const int mt = iq / ntn, nt = iq % ntn;
      const int KK = isq ? 192 : 128;
      const u16* A = isq ? (const u16*)(ws + OFF_CQ) : (const u16*)(ws + OFF_CKV);
      const u16* BT = isq ? ((const u16*)(ws + OFF_WUQT) + (size_t)layer * 384 * 192) : ((const u16*)(ws + OFF_WUKVT) + (size_t)layer * 512 * 128);
      __syncthreads();
      {
        const int r = tid >> 1, hf = tid & 1;
        const u16* rp = A + (size_t)(mt * 128 + r) * KK + hf * (KK / 2);
        float ss = 0.f;
        for (int i = 0; i < KK / 2; i += 8) {
          const u32x4 v = *(const u32x4*)(rp + i);
#pragma unroll
          for (int q = 0; q < 4; ++q) {
            const float lo = __uint_as_float(v[q] << 16), hi = __uint_as_float(v[q] & 0xffff0000u);
            ss += lo * lo + hi * hi;
          }
        }
        ss += __shfl_xor(ss, 1);
        if (hf == 0) srs[r] = rsqrtf(ss / (float)KK + EPSN);
      }
      LoadRows al{A + (size_t)mt * 128 * KK, KK}, bl{BT + (size_t)nt * 128 * KK, KK};
      if (isq) { EpiMlaQ epi{ws, srs, mt * 128}; gemm_dma(al, bl, KK, mt * 128, nt * 128, smem, epi); }
      else { EpiMlaKV epi{ws, srs, mt * 128}; gemm_dma(al, bl, KK, mt * 128, nt * 128, smem, epi); }
    } else {
      const int is = it - N_Q - N_KV;
      const int mt = is % 5, g = (is / 5) & 15, dir = is / 80;
      LoadS5A al{(const u16*)(ws + OFF_U5), (const u16*)(ws + OFF_HIN), g, mt * 128};
      LoadRows bl{(const u16*)(ws + OFF_W1) + ((size_t)((layer * 2 + dir) * 16 + g)) * 128 * 1024, 1024};
      EpiS1 epi{(float*)(ws + OFF_S5S), g, dir};
      gemm_dma(al, bl, 1024, mt * 128, 0, smem, epi);
    }
  }
}

template <int DK, int MODE>
__device__ __forceinline__ void attn_item(const u16* __restrict__ Qb, const u16* __restrict__ Kb, const u16* __restrict__ VTb, int qb,
                          u16* __restrict__ ymix, int ycol, int b, float sink_l2, const float* __restrict__ rpb_h, unsigned char* smem) {
  constexpr int KSTR = DK + 8;
  constexpr int VSTR = 68;
  constexpr int KCH = DK / 8;
  constexpr int NKL = (64 * KCH) / NT;
  constexpr int TILE_BYTES = 64 * KSTR * 2 + 64 * VSTR * 2;
  float* sBias = (float*)(smem + (ATT_T15 ? 3 : 2) * TILE_BYTES);
  const int tid = tidx(), lane = tid & 63, wave = tid >> 6;
  const int ql = lane & 31, hh = lane >> 5;
  const bool ctxq = qb >= 32;
  const int q0 = ctxq ? (4096 + (qb - 32) * 128) : qb * 128;
  const int myq = q0 + wave * 32 + ql;
  int seg0_start = 0, seg0_tiles = 0;
  if (!ctxq) {
    if (MODE == 0) { seg0_start = 0; seg0_tiles = 64; }
    else if (MODE == 1) { const int lo = (q0 - 128 < 0) ? 0 : q0 - 128; const int hi = (q0 + 256 > 4096) ? 4096 : q0 + 256; seg0_start = lo; seg0_tiles = (hi - lo) >> 6; }
    else { const int qr0 = q0 >> 6; int ra = qr0 - 4; ra = ra < 0 ? 0 : (ra > 56 ? 56 : ra); int rb = qr0 - 3; rb = rb < 0 ? 0 : (rb > 56 ? 56 : rb); seg0_start = ra * 64; seg0_tiles = rb + 8 - ra; }
  }
  const int ntiles = seg0_tiles + 4;
  __syncthreads();
  if (MODE == 2) {
    for (int i = tid; i < 15 * 31; i += NT) sBias[i] = rpb_h[i] * LOG2E;
  }
  bf16x8 qf[DK / 16];
#pragma unroll
  for (int st = 0; st < DK / 16; ++st) qf[st] = *(const bf16x8*)(Qb + (size_t)myq * DK + st * 16 + hh * 8);
  f32x16 o0, o1;
#pragma unroll
  for (int i = 0; i < 16; ++i) { o0[i] = 0.f; o1[i] = 0.f; }
  float mrow = 0.f, lsum = 0.f;
  const int qpos = myq;
  const int qrow = qpos >> 6, qcol = qpos & 63;
  int nr0 = qrow - 4; nr0 = nr0 < 0 ? 0 : (nr0 > 56 ? 56 : nr0);
  int ncs = qcol - 8; ncs = ncs < 0 ? 0 : (ncs > 48 ? 48 : ncs);

  u32x4 rk[NKL], rv[2];
  auto tile_start = [&](int t) { return (t < seg0_tiles) ? (seg0_start + t * 64) : (4096 + (t - seg0_tiles) * 64); };
  auto gload = [&](int t) {
    const int ks = tile_start(t);
#pragma unroll
    for (int i = 0; i < NKL; ++i) {
      const int id = tid + NT * i;
      const int row = id / KCH, c = id % KCH;
      rk[i] = *(const u32x4*)(Kb + (size_t)(ks + row) * DK + c * 8);
    }
#pragma unroll
    for (int i = 0; i < 2; ++i) {
      const int id = tid + NT * i;
      const int row = id >> 3, c = id & 7;
      rv[i] = *(const u32x4*)(VTb + (size_t)row * LK + ks + c * 8);
    }
  };
  auto lds_write = [&](int buf) {
    u16* wK = (u16*)(smem + buf * TILE_BYTES);
    u16* wV = (u16*)(smem + buf * TILE_BYTES + 64 * KSTR * 2);
#pragma unroll
    for (int i = 0; i < NKL; ++i) {
      const int id = tid + NT * i;
      const int row = id / KCH, c = id % KCH;
      *(u32x4*)(wK + row * KSTR + c * 8) = rk[i];
    }
#pragma unroll
    for (int i = 0; i < 2; ++i) {
      const int id = tid + NT * i;
      const int row = id >> 3, c = id & 7;
      u32x2 lo, hi; lo[0] = rv[i][0]; lo[1] = rv[i][1]; hi[0] = rv[i][2]; hi[1] = rv[i][3];
      *(u32x2*)(wV + row * VSTR + c * 8) = lo;
      *(u32x2*)(wV + row * VSTR + c * 8 + 4) = hi;
    }
  };
  auto qk_tile = [&](int buf, f32x16& a0, f32x16& a1) {
    const u16* sK = (const u16*)(smem + buf * TILE_BYTES);
    const float ini = -mrow;
#pragma unroll
    for (int i = 0; i < 16; ++i) { a0[i] = ini; a1[i] = ini; }
    bf16x8 kf0[DK / 16], kf1[DK / 16];
#pragma unroll
    for (int st = 0; st < DK / 16; ++st) {
      kf0[st] = *(const bf16x8*)(sK + ql * KSTR + st * 16 + hh * 8);
      kf1[st] = *(const bf16x8*)(sK + (32 + ql) * KSTR + st * 16 + hh * 8);
    }
    __builtin_amdgcn_sched_barrier(0);
    __builtin_amdgcn_s_setprio(1);
#pragma unroll
    for (int st = 0; st < DK / 16; ++st) {
      a0 = mfma32(kf0[st], qf[st], a0);
      a1 = mfma32(kf1[st], qf[st], a1);
    }
    __builtin_amdgcn_s_setprio(0);
  };
  auto apply_mask = [&](int t, f32x16& s0, f32x16& s1) {
    const int kt0 = tile_start(t);
    if (MODE != 0 && !ctxq && t < seg0_tiles) {
      if (MODE == 1) {
        const int qw = q0 + wave * 32;
        const bool all_valid = (kt0 + 63 - qw <= 128) && (qw + 31 - kt0 <= 128);
        if (!all_valid) {
          const int base = qpos - kt0 - 4 * hh;
#pragma unroll
          for (int i = 0; i < 16; ++i) {
            const int d0 = base - ((i & 3) + 8 * (i >> 2)), d1 = d0 - 32;
            if (d0 > 128 || d0 < -128) s0[i] = -INFINITY;
            if (d1 > 128 || d1 < -128) s1[i] = -INFINITY;
          }
        }
      } else {
        const int kr = kt0 >> 6;
        const int dr = kr - nr0;
        const bool rowok = (dr >= 0) && (dr < 8);
        if (!rowok) {
#pragma unroll
          for (int i = 0; i < 16; ++i) { s0[i] = -INFINITY; s1[i] = -INFINITY; }
        } else {
          const float* bb = sBias + (kr - qrow + 7) * 31 + (15 - qcol + 4 * hh);
          const int eb = 4 * hh - ncs;
#pragma unroll
          for (int i = 0; i < 16; ++i) {
            const int ci = (i & 3) + 8 * (i >> 2);
            const float b0 = bb[ci], b1 = bb[ci + 32];
            s0[i] = ((unsigned)(eb + ci) < 16u) ? (s0[i] + b0) : -INFINITY;
            s1[i] = ((unsigned)(eb + ci + 32) < 16u) ? (s1[i] + b1) : -INFINITY;
          }
        }
      }
    }
  };
#if ATT_T15
  if (true) {
    auto pv = [&](int buf, f32x16& p0, f32x16& p1) {
      const u16* sV = (const u16*)(smem + buf * TILE_BYTES + 64 * KSTR * 2);
      __builtin_amdgcn_s_setprio(1);
#pragma unroll
      for (int kb = 0; kb < 2; ++kb) {
#pragma unroll
        for (int sp = 0; sp < 2; ++sp) {
          union { bf16x8 v; unsigned u[4]; } pf;
#pragma unroll
          for (int q = 0; q < 4; ++q) {
            const float a = kb ? p1[8 * sp + 2 * q] : p0[8 * sp + 2 * q];
            const float c = kb ? p1[8 * sp + 2 * q + 1] : p0[8 * sp + 2 * q + 1];
            pf.u[q] = pack2(a, c);
          }
          const int koff = 32 * kb + 16 * sp + 4 * hh;
          union { bf16x8 v; u32x2 h[2]; } v0, v1;
          v0.h[0] = *(const u32x2*)(sV + ql * VSTR + koff);
          v0.h[1] = *(const u32x2*)(sV + ql * VSTR + koff + 8);
          v1.h[0] = *(const u32x2*)(sV + (32 + ql) * VSTR + koff);
          v1.h[1] = *(const u32x2*)(sV + (32 + ql) * VSTR + koff + 8);
          o0 = mfma32(v0.v, pf.v, o0);
          o1 = mfma32(v1.v, pf.v, o1);
        }
      }
      __builtin_amdgcn_s_setprio(0);
    };
    auto qk_overlap = [&](int buf, f32x16& a0, f32x16& a1, f32x16& c0, f32x16& c1, float& ps) {
      const u16* sK = (const u16*)(smem + buf * TILE_BYTES);
      const float ini = -mrow;
#pragma unroll
      for (int i = 0; i < 16; ++i) { a0[i] = ini; a1[i] = ini; }
      bf16x8 ka = *(const bf16x8*)(sK + ql * KSTR + hh * 8);
      bf16x8 kc = *(const bf16x8*)(sK + (32 + ql) * KSTR + hh * 8);
#pragma unroll
      for (int st = 0; st < DK / 16; ++st) {
#pragma unroll
        for (int half = 0; half < 2; ++half) {
          if (half == 0) {
            a0 = mfma32(ka, qf[st], a0);
            if (st + 1 < DK / 16) ka = *(const bf16x8*)(sK + ql * KSTR + (st + 1) * 16 + hh * 8);
          } else {
            a1 = mfma32(kc, qf[st], a1);
            if (st + 1 < DK / 16) kc = *(const bf16x8*)(sK + (32 + ql) * KSTR + (st + 1) * 16 + hh * 8);
          }
          const int slot = 2 * st + half;
          constexpr int NSLOT = DK / 8;
          const int v0i = (32 * slot) / NSLOT, v1i = (32 * (slot + 1)) / NSLOT;
#pragma unroll
          for (int v = v0i; v < v1i; ++v) {
            if (v < 16) { c0[v] = __builtin_amdgcn_exp2f(c0[v]); ps += c0[v]; }
            else { c1[v - 16] = __builtin_amdgcn_exp2f(c1[v - 16]); ps += c1[v - 16]; }
          }
          __builtin_amdgcn_sched_barrier(0);
        }
      }
    };
    auto qk_lean = [&](int buf, f32x16& a0, f32x16& a1) {
      const u16* sK = (const u16*)(smem + buf * TILE_BYTES);
      const float ini = -mrow;
#pragma unroll
      for (int i = 0; i < 16; ++i) { a0[i] = ini; a1[i] = ini; }
#pragma unroll
      for (int st = 0; st < DK / 16; ++st) {
        const bf16x8 ka = *(const bf16x8*)(sK + ql * KSTR + st * 16 + hh * 8);
        const bf16x8 kc = *(const bf16x8*)(sK + (32 + ql) * KSTR + st * 16 + hh * 8);
        a0 = mfma32(ka, qf[st], a0);
        a1 = mfma32(kc, qf[st], a1);
        __builtin_amdgcn_sched_barrier(0);
      }
    };
    int bc = 0, bn = 1, bw = 2;
    auto prelude = [&](int t, f32x16& c0, f32x16& c1) {
      apply_mask(t, c0, c1);
      float mx = c0[0];
#pragma unroll
      for (int i = 1; i < 16; ++i) mx = fmaxf(mx, c0[i]);
#pragma unroll
      for (int i = 0; i < 16; ++i) mx = fmaxf(mx, c1[i]);
      mx = fmaxf(mx, __shfl_xor(mx, 32));
      const bool slow = (t == 0) || (__builtin_amdgcn_ballot_w64(mx > 8.0f) != 0ull);
      if (slow) {
        const float dm = (t == 0) ? ((mx > -1e30f) ? mx : 0.f) : fmaxf(mx, 0.f);
        const float alpha = __builtin_amdgcn_exp2f(-dm);
        mrow += dm;
        lsum *= alpha;
#pragma unroll
        for (int i = 0; i < 16; ++i) { c0[i] -= dm; c1[i] -= dm; o0[i] *= alpha; o1[i] *= alpha; }
      }
    };
    auto step = [&](int t, f32x16& c0, f32x16& c1, f32x16& n0, f32x16& n1) {
      if (t + 2 < ntiles) lds_write(bw);
      prelude(t, c0, c1);
      float ps = 0.f;
      qk_overlap(bn, n0, n1, c0, c1, ps);
      lsum += ps;
      if (t + 3 < ntiles) gload(t + 3);
      pv(bc, c0, c1);
      __syncthreads();
      const int ob = bc; bc = bn; bn = bw; bw = ob;
    };
    auto last = [&](int t, f32x16& c0, f32x16& c1) {
      prelude(t, c0, c1);
      float ps = 0.f;
#pragma unroll
      for (int i = 0; i < 16; ++i) { c0[i] = __builtin_amdgcn_exp2f(c0[i]); ps += c0[i]; }
#pragma unroll
      for (int i = 0; i < 16; ++i) { c1[i] = __builtin_amdgcn_exp2f(c1[i]); ps += c1[i]; }
      lsum += ps;
      pv(bc, c0, c1);
      __syncthreads();
    };
    gload(0);
    lds_write(0);
    if (ntiles > 1) gload(1);
    __syncthreads();
    f32x16 pa0, pa1, pb0, pb1;
    qk_lean(0, pa0, pa1);
    if (ntiles > 1) lds_write(1);
    if (ntiles > 2) gload(2);
    __syncthreads();
    int t = 0;
    for (; t + 2 < ntiles; t += 2) {
      step(t, pa0, pa1, pb0, pb1);
      step(t + 1, pb0, pb1, pa0, pa1);
    }
    if (t + 1 < ntiles) { step(t, pa0, pa1, pb0, pb1); last(t + 1, pb0, pb1); }
    else last(t, pa0, pa1);
  } else
#endif
  {
  gload(0);
  lds_write(0);
  if (ntiles > 1) gload(1);
  __syncthreads();
  f32x16 s0, s1;
  for (int t = 0; t < ntiles; ++t) {
    const int bcur = t & 1;
    if (t + 1 < ntiles) lds_write(bcur ^ 1);
    if (t + 2 < ntiles) gload(t + 2);
    qk_tile(bcur, s0, s1);
    const u16* sV = (const u16*)(smem + bcur * TILE_BYTES + 64 * KSTR * 2);
    apply_mask(t, s0, s1);
    float mx = s0[0];
#pragma unroll
    for (int i = 1; i < 16; ++i) mx = fmaxf(mx, s0[i]);
#pragma unroll
    for (int i = 0; i < 16; ++i) mx = fmaxf(mx, s1[i]);
    mx = fmaxf(mx, __shfl_xor(mx, 32));
    const bool slow = (t == 0) || (__builtin_amdgcn_ballot_w64(mx > 8.0f) != 0ull);
    float ps = 0.f;
    if (slow) {
      const float dm = (t == 0) ? ((mx > -1e30f) ? mx : 0.f) : fmaxf(mx, 0.f);
      const float alpha = __builtin_amdgcn_exp2f(-dm);
      mrow += dm;
#pragma unroll
      for (int i = 0; i < 16; ++i) { s0[i] = __builtin_amdgcn_exp2f(s0[i] - dm); ps += s0[i]; }
#pragma unroll
      for (int i = 0; i < 16; ++i) { s1[i] = __builtin_amdgcn_exp2f(s1[i] - dm); ps += s1[i]; }
      lsum = lsum * alpha + ps;
#pragma unroll
      for (int i = 0; i < 16; ++i) { o0[i] *= alpha; o1[i] *= alpha; }
    } else {
#pragma unroll
      for (int i = 0; i < 16; ++i) { s0[i] = __builtin_amdgcn_exp2f(s0[i]); ps += s0[i]; }
#pragma unroll
      for (int i = 0; i < 16; ++i) { s1[i] = __builtin_amdgcn_exp2f(s1[i]); ps += s1[i]; }
      lsum += ps;
    }
    __builtin_amdgcn_s_setprio(1);
#pragma unroll
    for (int kb = 0; kb < 2; ++kb) {
#pragma unroll
      for (int sp = 0; sp < 2; ++sp) {
        union { bf16x8 v; unsigned u[4]; } pf;
#pragma unroll
        for (int q = 0; q < 4; ++q) {
          const float a = kb ? s1[8 * sp + 2 * q] : s0[8 * sp + 2 * q];
          const float c = kb ? s1[8 * sp + 2 * q + 1] : s0[8 * sp + 2 * q + 1];
          pf.u[q] = pack2(a, c);
        }
        const int koff = 32 * kb + 16 * sp + 4 * hh;
        union { bf16x8 v; u32x2 h[2]; } v0, v1;
        v0.h[0] = *(const u32x2*)(sV + ql * VSTR + koff);
        v0.h[1] = *(const u32x2*)(sV + ql * VSTR + koff + 8);
        v1.h[0] = *(const u32x2*)(sV + (32 + ql) * VSTR + koff);
        v1.h[1] = *(const u32x2*)(sV + (32 + ql) * VSTR + koff + 8);
        o0 = mfma32(v0.v, pf.v, o0);
        o1 = mfma32(v1.v, pf.v, o1);
      }
    }
    __builtin_amdgcn_s_setprio(0);
    __syncthreads();
  }
  }
  float ltot = lsum + __shfl_xor(lsum, 32);
  if (MODE == 1) ltot += __builtin_amdgcn_exp2f(sink_l2 - mrow);
  const float inv = 1.0f / ltot;
  const int orow = ctxq ? (NLAT + b * 256 + (myq - 4096)) : (b * 4096 + myq);
  u16* dst = ymix + (size_t)orow * 1024 + ycol;
#pragma unroll
  for (int g4 = 0; g4 < 4; ++g4) {
    const int dv = 8 * g4 + 4 * hh;
    u32x2 pa, pb;
    pa[0] = pack2(o0[4 * g4] * inv, o0[4 * g4 + 1] * inv); pa[1] = pack2(o0[4 * g4 + 2] * inv, o0[4 * g4 + 3] * inv);
    pb[0] = pack2(o1[4 * g4] * inv, o1[4 * g4 + 1] * inv); pb[1] = pack2(o1[4 * g4 + 2] * inv, o1[4 * g4 + 3] * inv);
    *(u32x2*)(dst + dv) = pa;
    *(u32x2*)(dst + 32 + dv) = pb;
  }
}

__device__ __forceinline__ void s5_carry_item(KP kp, int layer, int item) {
  unsigned char* ws = kp->ws;
  {
      const int e = item * NT + tidx();
      const int pp = e & 63, dir = (e >> 6) & 1, g = (e >> 7) & 15, bb = e >> 11;
      const float2 a64 = ((const float2*)(ws + OFF_APOW))[(size_t)(((layer * 2 + dir) * 16 + g) * 64 + pp) * 65 + 64];
      const float* S = (const float*)(ws + OFF_S5S);
      u16* Hin = (u16*)(ws + OFF_HIN);
      float2 H = make_float2(0.f, 0.f);
#pragma unroll 1
      for (int i0 = 0; i0 < 68; i0 += 17) {
        float2 sv[17];
#pragma unroll
        for (int u = 0; u < 17; ++u) {
          const int i = i0 + u;
          const int c = (dir == 0) ? ((i < 4) ? (64 + i) : (i - 4)) : (67 - i);
          sv[u] = *(const float2*)(S + (((size_t)(bb * 68 + c) * 16 + g) * 2 + dir) * 128 + pp * 2);
        }
#pragma unroll
        for (int u = 0; u < 17; ++u) {
          const int i = i0 + u;
          const int c = (dir == 0) ? ((i < 4) ? (64 + i) : (i - 4)) : (67 - i);
          *(unsigned*)(Hin + ((size_t)(bb * 68 + c) * 16 + g) * 256 + dir * 128 + pp * 2) = pack2(H.x, H.y);
          const float2 ah = cmul(a64, H);
          H = make_float2(ah.x + sv[u].x, ah.y + sv[u].y);
        }
      }
  }
}
__device__ __forceinline__ void phase4(KP kp, int layer, unsigned char* smem) {
  unsigned char* ws = kp->ws;
  const int n_lat = NB * 4 * 32;
  const int n_ctx = (layer == 0) ? NB * 4 * 2 : 0;
  const int n_carry = 0;
  const int total = 2 * n_lat + n_carry + 2 * n_ctx;
  u16* ymix = (u16*)(ws + OFF_H);
  for (int it = bidx(); it < total; it += gridDim.x) {
    int mixer, qb, head, b;
    bool carry = false;
    if (it < 2 * n_lat) {
      mixer = it / n_lat;
      const int ia = it % n_lat;
      const int x = ia & 7, li = ia >> 3;
      const int pid = x + 8 * (li >> 5);
      qb = li & 31; head = pid & 3; b = pid >> 2;
    }
    else if (it < 2 * n_lat + n_carry) { carry = true; mixer = 0; qb = 0; head = 0; b = 0; }
    else { const int ic = it - 2 * n_lat - n_carry; mixer = ic / n_ctx; const int ia = ic % n_ctx; qb = 32 + (ia & 1); head = (ia >> 1) & 3; b = ia >> 3; }
    if (carry) {
    } else if (mixer == 0) {
      const int kvh = head >> 1;
      const u16* Qb = (const u16*)(ws + OFF_QA) + (size_t)(b * 4 + head) * LK * 64;
      const u16* Kb = (const u16*)(ws + OFF_KA) + (size_t)(b * 2 + kvh) * LK * 64;
      const u16* VTb = (const u16*)(ws + OFF_VTA) + (size_t)(b * 2 + kvh) * 64 * LK;
      const float sink = kp->in[I_SINK][layer * 4 + head] * LOG2E;
      attn_item<64, 1>(Qb, Kb, VTb, qb, ymix, head * 64, b, sink, nullptr, smem);
    } else {
      const u16* Qb = (const u16*)(ws + OFF_QD) + (size_t)(b * 4 + head) * LK * 64;
      const u16* Kb = (const u16*)(ws + OFF_KD) + (size_t)(b * 4 + head) * LK * 64;
      const u16* VTb = (const u16*)(ws + OFF_VTD) + (size_t)(b * 4 + head) * 64 * LK;
      attn_item<64, 2>(Qb, Kb, VTb, qb, ymix, 768 + head * 64, b, 0.f, kp->in[I_RPB] + (size_t)(layer * 4 + head) * 15 * 31, smem);
    }
  }
}

struct LoadS5B {
  const u16* tt; const u16* st; int g, n0;
  __device__ __forceinline__ const u16* operator()(int r, int k) const {
    const int n = n0 + r;
    if (k < 1024) return tt + (((size_t)g * 127 + ((n >> 4) - (k >> 4) + 63)) * 16 + (n & 15)) * 16 + (k & 15);
    return st + ((size_t)g * 1024 + n) * 256 + (k - 1024);
  }
};
struct EpiS3 {
  u16* YG; int g;
  __device__ __forceinline__ void operator()(int row0, int col0, f32x4 (&acc)[4][4], int lane) const {
    const int cl = lane & 15, rq = lane >> 4;
#pragma unroll
    for (int mi = 0; mi < 4; ++mi)
#pragma unroll
      for (int j = 0; j < 4; ++j) {
        const int cidx = row0 + mi * 16 + rq * 4 + j;
        if (cidx < 544) {
          const int r0 = chunk_row0(cidx);
#pragma unroll
          for (int ni = 0; ni < 4; ++ni) {
            const int jt = (col0 >> 4) + ni;
            YG[(size_t)(r0 + jt) * 256 + g * 16 + cl] = f2bf(gelu_tanh(acc[mi][ni][j]));
          }
        }
      }
  }
};
__device__ __forceinline__ void phase5(KP kp, int layer, unsigned char* smem, int sub = 0) {
  unsigned char* ws = kp->ws;
  const int n_lat = NB * 4 * 32;
  const int n_ctx = (layer == 0) ? NB * 4 * 2 : 0;
  const int n_att = n_lat + n_ctx;
  const int n_s3 = 16 * 5 * 8;
  u16* ymix = (u16*)(ws + OFF_H);
  unsigned* cctr = (unsigned*)(ws + OFF_BAR) + XB_QUEUE(layer);
  if (bidx() >= (int)gridDim.x - 64 && gridDim.x >= 64) {
    s5_carry_item(kp, layer, bidx() - ((int)gridDim.x - 64));
    __threadfence();
    asm volatile("s_waitcnt vmcnt(0)" ::: "memory");
    __syncthreads();
    if (tidx() == 0) (void)xb_add(cctr, 1u);
  }
  bool carry_seen = false;
  for (int it = bidx(); it < n_att + n_s3; it += gridDim.x) {
    if (sub == 1 && it >= n_att) break;
    if (sub == 2 && it < n_att) continue;
    if (it >= n_att && !carry_seen) {
      if (tidx() == 0) { XB_SPIN(xb_ld(cctr) < 64u, (unsigned*)(ws + OFF_BAR)); }
      __syncthreads();
      __builtin_amdgcn_fence(__ATOMIC_ACQUIRE, "agent");
      carry_seen = true;
    }
    if (it < n_att) {
      int qb, head, b;
      if (it < n_lat) {
        const int x = it & 7, li = it >> 3;
        const int pid = x + 8 * (li >> 5);
        qb = li & 31; head = pid & 3; b = pid >> 2;
      } else { const int ia = it - n_lat; qb = 32 + (ia & 1); head = (ia >> 1) & 3; b = ia >> 3; }
      const u16* Qb = (const u16*)(ws + OFF_QB) + (size_t)(b * 4 + head) * LK * 96;
      const u16* Kb = (const u16*)(ws + OFF_KB) + (size_t)(b * 4 + head) * LK * 96;
      const u16* VTb = (const u16*)(ws + OFF_VTB) + (size_t)(b * 4 + head) * 64 * LK;
      attn_item<96, 0>(Qb, Kb, VTb, qb, ymix, 256 + head * 64, b, 0.f, nullptr, smem);
    } else {
      const int is = it - n_att;
      const int nt = is & 7, mt = (is >> 3) % 5, g = is / 40;
      LoadS5A al{(const u16*)(ws + OFF_U5), (const u16*)(ws + OFF_HIN), g, mt * 128};
      LoadS5B bl{(const u16*)(ws + OFF_TT), (const u16*)(ws + OFF_ST), g, nt * 128};
      EpiS3 epi{(u16*)(ws + OFF_YG), g};
      gemm_dma(al, bl, 1280, mt * 128, nt * 128, smem, epi);
    }
  }
}

struct EpiGlu {
  u16* ymix;
  __device__ __forceinline__ void operator()(int row0, int col0, f32x4 (&acc)[4][4], int lane) const {
    const int cl = lane & 15, rq = lane >> 4;
#pragma unroll
    for (int mi = 0; mi < 4; ++mi)
#pragma unroll
      for (int q = 0; q < 2; ++q)
#pragma unroll
        for (int j = 0; j < 4; ++j) {
          const int r = row0 + mi * 16 + rq * 4 + j;
          const float a = acc[mi][2 * q][j], gg = acc[mi][2 * q + 1][j];
          ymix[(size_t)r * 1024 + 512 + ((col0 >> 5) + q) * 16 + cl] = f2bf(a * sigmoidf_(gg));
        }
  }
};
__device__ __forceinline__ void phase6(KP kp, int layer, unsigned char* smem) {
  unsigned char* ws = kp->ws;
  const int mrows = (layer == 0) ? MTOT : NLAT;
  const int tid = tidx(), lane = tid & 63, wave = tid >> 6;
  u16* ymix = (u16*)(ws + OFF_H);
  EpiGlu epi{ymix};
  for (int mt = bidx(); mt < mrows / 128; mt += gridDim.x) {
    for (int nt = 0; nt < 4; ++nt) {
      LoadRows al{(const u16*)(ws + OFF_YG) + (size_t)mt * 128 * 256, 256};
      LoadRows bl{(const u16*)(ws + OFF_WGLUT) + (size_t)layer * 512 * 256 + (size_t)nt * 128 * 256, 256};
      gemm_dma(al, bl, 256, mt * 128, nt * 128, smem, epi);
    }
    asm volatile("s_waitcnt vmcnt(0)" ::: "memory");
    __syncthreads();
#pragma unroll 1
    for (int rb = 0; rb < 32; rb += 4) {
      u32x4 va[4], vb[4];
#pragma unroll
      for (int u = 0; u < 4; ++u) {
        const u32x4* ptr = (const u32x4*)(ymix + (size_t)(mt * 128 + wave * 32 + rb + u) * 1024 + lane * 16);
        va[u] = ptr[0]; vb[u] = ptr[1];
      }
#pragma unroll
      for (int u = 0; u < 4; ++u) {
        float f[16];
#pragma unroll
        for (int q = 0; q < 4; ++q) {
          f[2 * q] = __uint_as_float(va[u][q] << 16); f[2 * q + 1] = __uint_as_float(va[u][q] & 0xffff0000u);
          f[8 + 2 * q] = __uint_as_float(vb[u][q] << 16); f[8 + 2 * q + 1] = __uint_as_float(vb[u][q] & 0xffff0000u);
        }
        float ss = 0.f;
#pragma unroll
        for (int q = 0; q < 16; ++q) ss += f[q] * f[q];
#pragma unroll
        for (int o = 8; o >= 1; o >>= 1) ss += __shfl_xor(ss, o);
        const float rstd = rsqrtf(ss * (1.0f / 256.0f) + EPSN);
        const int row = mt * 128 + wave * 32 + rb + u;
        float am = 0.f;
#pragma unroll
        for (int q = 0; q < 16; ++q) am = fmaxf(am, fabsf(f[q]));
        am *= rstd;
#pragma unroll
        for (int o = 32; o >= 1; o >>= 1) am = fmaxf(am, __shfl_xor(am, o));
        am = fmaxf(am, 1e-20f);
        const float qs = rstd * 127.0f / am;
        if (lane == 0) ((float*)(ws + OFF_TS))[row] = am * (1.0f / 127.0f);
        u32x4 w8;
#pragma unroll
        for (int q = 0; q < 4; ++q) {
          unsigned w = 0;
#pragma unroll
          for (int j = 0; j < 4; ++j) w |= ((unsigned)((int)rintf(f[4 * q + j] * qs)) & 0xffu) << (8 * j);
          w8[q] = w;
        }
        *(u32x4*)(ws + OFF_H8 + ((size_t)(lane >> 1) * MTOT + row) * 32 + (lane & 1) * 16) = w8;
      }
    }
  }
}

__device__ __forceinline__ void phase7(KP kp, int layer) {
  const int lane = tidx() & 63;
  const int gw = (bidx() * NT + tidx()) >> 6, nw = (gridDim.x * NT) >> 6;
  const int mrows = (layer == 0) ? MTOT : NLAT;
  u16* ymix = (u16*)(kp->ws + OFF_H);
  for (int r0 = gw; r0 < mrows; r0 += 4 * nw) {
    u32x4 va[4], vb[4];
#pragma unroll
    for (int u = 0; u < 4; ++u) {
      const int r = (r0 + u * nw < mrows) ? (r0 + u * nw) : r0;
      const u32x4* ptr = (const u32x4*)(ymix + (size_t)r * 1024 + lane * 16);
      va[u] = ptr[0]; vb[u] = ptr[1];
    }
#pragma unroll
    for (int u = 0; u < 4; ++u) {
      const int r = r0 + u * nw;
      if (r >= mrows) break;
      float f[16];
#pragma unroll
      for (int q = 0; q < 4; ++q) {
        f[2 * q] = __uint_as_float(va[u][q] << 16); f[2 * q + 1] = __uint_as_float(va[u][q] & 0xffff0000u);
        f[8 + 2 * q] = __uint_as_float(vb[u][q] << 16); f[8 + 2 * q + 1] = __uint_as_float(vb[u][q] & 0xffff0000u);
      }
      float ss = 0.f;
#pragma unroll
      for (int q = 0; q < 16; ++q) ss += f[q] * f[q];
#pragma unroll
      for (int o = 8; o >= 1; o >>= 1) ss += __shfl_xor(ss, o);
      const float rstd = rsqrtf(ss * (1.0f / 256.0f) + EPSN);
      u32x4 o0, o1;
#pragma unroll
      for (int q = 0; q < 4; ++q) {
        o0[q] = pack2(f[2 * q] * rstd, f[2 * q + 1] * rstd);
        o1[q] = pack2(f[8 + 2 * q] * rstd, f[8 + 2 * q + 1] * rstd);
      }
      u32x4* ptr = (u32x4*)(ymix + (size_t)r * 1024 + lane * 16);
      ptr[0] = o0; ptr[1] = o1;
    }
  }
}

struct EpiOut {
  const float* xlat; const float* xctx; float* olat; float* octx; const float* modl;
  __device__ __forceinline__ void operator()(int row0, int col0, f32x4 (&acc)[4][4], int lane) const {
    const int cl = lane & 15, rq = lane >> 4;
    const bool is_lat = row0 < NLAT;
    const int bb = is_lat ? (row0 >> 12) : 8;
#pragma unroll
    for (int mi = 0; mi < 4; ++mi) {
      const int r = row0 + mi * 16 + cl;
      const float* xin = is_lat ? (xlat + (size_t)r * 1024) : (xctx + (size_t)(r - NLAT) * 1024);
      float* xo = is_lat ? (olat + (size_t)r * 1024) : (octx + (size_t)(r - NLAT) * 1024);
#pragma unroll
      for (int ni = 0; ni < 4; ++ni) {
        const int col = col0 + ni * 16 + rq * 4;
        const f32x4 g1 = *(const f32x4*)(modl + (size_t)bb * 6144 + 2048 + col);
        const f32x4 xi = *(const f32x4*)(xin + col);
        f32x4 o;
#pragma unroll
        for (int j = 0; j < 4; ++j) o[j] = xi[j] + g1[j] * acc[mi][ni][j];
        *(f32x4*)(xo + col) = o;
      }
    }
  }
};
__device__ __forceinline__ void phase8(KP kp, int layer, unsigned char* smem) {
  unsigned char* ws = kp->ws;
  EpiOut epi;
  epi.xlat = (layer == 0) ? kp->in[I_X] : kp->out;
  epi.xctx = kp->in[I_CTX];
  epi.olat = kp->out;
  epi.octx = (float*)(ws + OFF_XC);
  epi.modl = (const float*)(ws + OFF_MOD) + (size_t)layer * 9 * 6144;
  const u16* A = (const u16*)(ws + OFF_MIX);
  const u16* BT = (const u16*)(ws + OFF_WOUTT) + (size_t)layer * 1024 * 1024;
  const int bid = bidx(), nblk = gridDim.x;
  for (int r = 0;; ++r) {
    int mt, nt;
    if (!xcd_tile(bid, nblk, r, NLAT / 256, 8, mt, nt)) break;
    LoadKB8 al{(const unsigned char*)(ws + OFF_H8) + (size_t)mt * 256 * 32, MTOT};
    LoadKB8 bl{(const unsigned char*)(ws + OFF_WOUT8) + (size_t)layer * 1024 * 1024 + (size_t)nt * 128 * 32, 1024};
    EpiI8<true, EpiOut> e8{epi, (const float*)(ws + OFF_TS), 1.0f / WQ8_SCALE};
    gemm_dma3_i8<true>(al, bl, 1024, mt * 256, nt * 128, smem, e8);
  }
  if (layer == 0) {
    for (int it = bid; it < 16 * 8; it += nblk) {
      const int mt = NLAT / 128 + (it >> 3), nt = it & 7;
      LoadKB8 al{(const unsigned char*)(ws + OFF_H8) + (size_t)mt * 128 * 32, MTOT};
      LoadKB8 bl{(const unsigned char*)(ws + OFF_WOUT8) + (size_t)layer * 1024 * 1024 + (size_t)nt * 128 * 32, 1024};
      EpiI8<true, EpiOut> e8{epi, (const float*)(ws + OFF_TS), 1.0f / WQ8_SCALE};
      gemm_dma3_i8<true, 1>(al, bl, 1024, mt * 128, nt * 128, smem, e8);
    }
  }
}

__device__ __forceinline__ void phase9(KP kp, int layer) {
  const int mrows = (layer == 0) ? MTOT : NLAT;
  norm_mod_rows<true, true>(kp->out, (const float*)(kp->ws + OFF_XC), kp->in[I_N2G] + layer * 1024, (const float*)(kp->ws + OFF_MOD) + (size_t)layer * 9 * 6144,
                3072, 4096, (u16*)(kp->ws + OFF_H), mrows, kp->ws + OFF_H8, (float*)(kp->ws + OFF_TS));
}

struct EpiQ {
  u16* q;
  __device__ __forceinline__ void operator()(int row0, int col0, f32x4 (&acc)[4][4], int lane) const {
    const int cl = lane & 15, rq = lane >> 4;
#pragma unroll
    for (int mi = 0; mi < 4; ++mi)
#pragma unroll
      for (int ni = 0; ni < 4; ++ni) {
        u32x2 pk; pk[0] = pack2(acc[mi][ni][0], acc[mi][ni][1]); pk[1] = pack2(acc[mi][ni][2], acc[mi][ni][3]);
        *(u32x2*)(q + (size_t)(row0 + mi * 16 + cl) * 2048 + col0 + ni * 16 + rq * 4) = pk;
      }
  }
};
struct EpiQ8 {
  u16* q; const float* ts; float sw;
  __device__ __forceinline__ void operator()(int row0, int col0, i32x4 (&acc)[4][4], int lane) const {
    const int cl = lane & 15, rq = lane >> 4;
#pragma unroll
    for (int mi = 0; mi < 4; ++mi) {
      const float s = ts[row0 + mi * 16 + cl] * sw;
#pragma unroll
      for (int ni = 0; ni < 4; ++ni) {
        u32x2 pk; pk[0] = pack2((float)acc[mi][ni][0] * s, (float)acc[mi][ni][1] * s); pk[1] = pack2((float)acc[mi][ni][2] * s, (float)acc[mi][ni][3] * s);
        *(u32x2*)(q + (size_t)(row0 + mi * 16 + cl) * 2048 + col0 + ni * 16 + rq * 4) = pk;
      }
    }
  }
};
__device__ __forceinline__ void phase10(KP kp, int layer, unsigned char* smem) {
  unsigned char* ws = kp->ws;
  EpiQ epi{(u16*)(ws + OFF_QPEER)};
  const u16* A = (const u16*)(ws + OFF_H);
  const u16* BT = (const u16*)(ws + OFF_WQT) + (size_t)layer * 2048 * 1024;
  const int bid = bidx(), nblk = gridDim.x;
  for (int r = 0;; ++r) {
    int mt, nt;
    if (!xcd_tile(bid, nblk, r, NLAT / 256, 16, mt, nt)) break;
    LoadKB8 al{(const unsigned char*)(ws + OFF_H8) + (size_t)mt * 256 * 32, MTOT};
    LoadKB8 bl{(const unsigned char*)(ws + OFF_WQ8) + (size_t)layer * 2048 * 1024 + (size_t)nt * 128 * 32, 2048};
    EpiQ8 epi8{(u16*)(ws + OFF_QPEER), (const float*)(ws + OFF_TS), 1.0f / WQ8_SCALE};
    gemm_dma3_i8<true>(al, bl, 1024, mt * 256, nt * 128, smem, epi8);
  }
  if (layer == 0) {
    for (int it = bid; it < 16 * 16; it += nblk) {
      const int mt = NLAT / 128 + (it >> 4), nt = it & 15;
      LoadKB8 al{(const unsigned char*)(ws + OFF_H8) + (size_t)mt * 128 * 32, MTOT};
      LoadKB8 bl{(const unsigned char*)(ws + OFF_WQ8) + (size_t)layer * 2048 * 1024 + (size_t)nt * 128 * 32, 2048};
      EpiQ8 epi8{(u16*)(ws + OFF_QPEER), (const float*)(ws + OFF_TS), 1.0f / WQ8_SCALE};
      gemm_dma3_i8<true, 1>(al, bl, 1024, mt * 128, nt * 128, smem, epi8);
    }
  }
}

#define CE_DESC(x, y) { const float hi_ = fmaxf(x, y); const float lo_ = fminf(x, y); x = hi_; y = lo_; }
template <int N>
__device__ __forceinline__ void bitonic_sort_desc(float (&a)[N]) {
#pragma unroll
  for (int k = 2; k <= N; k <<= 1)
#pragma unroll
    for (int jj = k >> 1; jj > 0; jj >>= 1)
#pragma unroll
      for (int i = 0; i < N; ++i) {
        const int l = i ^ jj;
        if (l > i) {
          if ((i & k) == 0) CE_DESC(a[i], a[l]) else CE_DESC(a[l], a[i])
        }
      }
}
__device__ __forceinline__ void bitonic_merge16_desc(float (&a)[16]) {
#pragma unroll
  for (int jj = 8; jj > 0; jj >>= 1)
#pragma unroll
    for (int i = 0; i < 16; ++i) {
      const int l = i ^ jj;
      if (l > i) CE_DESC(a[i], a[l])
    }
}
__device__ __forceinline__ void merge_top16(float (&a)[16], const float (&b)[16]) {
#pragma unroll
  for (int i = 0; i < 16; ++i) a[i] = fmaxf(a[i], b[15 - i]);
  bitonic_merge16_desc(a);
}
__device__ __forceinline__ void merge_top16_xlane(float (&a)[16], int xmask) {
  float o[16];
#pragma unroll
  for (int i = 0; i < 16; ++i) o[i] = __shfl_xor(a[15 - i], xmask);
#pragma unroll
  for (int i = 0; i < 16; ++i) a[i] = fmaxf(a[i], o[i]);
  bitonic_merge16_desc(a);
}
__device__ __forceinline__ float packc(float v, unsigned code) { return __uint_as_float((__float_as_uint(v) & ~255u) | code); }
__device__ __forceinline__ void phase11(KP kp, int layer, unsigned char* smem) {
  unsigned char* ws = kp->ws;
  const int tid = tidx(), lane = tid & 63, wave = tid >> 6, ql = lane & 31, hh = lane >> 5;
  const int mrows = (layer == 0) ? MTOT : NLAT;
  const u16* Q = (const u16*)(ws + OFF_QPEER);
  const u16* SK = (const u16*)(ws + OFF_SUBK) + (size_t)layer * 2 * 128 * 128;
  u16* IDX = (u16*)(ws + OFF_IDX);
  float* GATE = (float*)(ws + OFF_GATE);
  unsigned* sL = (unsigned*)(smem + 65536);
  u16* sSK = (u16*)smem;
  const int jh = wave & 1, pb = wave >> 1;
  const int pr = pb * 32 + ql;
  __syncthreads();
#pragma unroll
  for (int i = 0; i < 16; ++i) {
    const int id = tid + NT * i;
    const int row = id >> 4, c = id & 15;
    *(u32x4*)(sSK + row * 128 + ((c ^ (row & 15)) * 8)) = *(const u32x4*)(SK + (size_t)row * 128 + c * 8);
  }
  __syncthreads();
  for (int it = bidx(); it < mrows / 8; it += gridDim.x) {
    const int tok0 = it * 8;
    const u16* qrow = Q + (size_t)(tok0 + (pr >> 3)) * 2048 + (pr & 7) * 256 + jh * 128 + hh * 8;
    bf16x8 qf[8];
#pragma unroll
    for (int st = 0; st < 8; ++st) qf[st] = *(const bf16x8*)(qrow + st * 16);
    float top[16];
#pragma unroll
    for (int kt = 0; kt < 4; ++kt) {
      f32x16 acc;
#pragma unroll
      for (int i = 0; i < 16; ++i) acc[i] = 0.f;
#pragma unroll
      for (int st = 0; st < 8; ++st) {
        const int krow = jh * 128 + kt * 32 + ql;
        const bf16x8 kf = *(const bf16x8*)(sSK + krow * 128 + (((st * 2 + hh) ^ (krow & 15)) * 8));
        acc = mfma32(kf, qf[st], acc);
      }
      float v[16];
#pragma unroll
      for (int i = 0; i < 16; ++i)
        v[i] = __uint_as_float((__float_as_uint(acc[i]) & ~127u) | (unsigned)(32 * kt + (i & 3) + 8 * (i >> 2)) | (unsigned)(hh << 2));
      bitonic_sort_desc<16>(v);
      if (kt == 0) {
#pragma unroll
        for (int i = 0; i < 16; ++i) top[i] = v[i];
      } else merge_top16(top, v);
    }
    merge_top16_xlane(top, 32);
    __syncthreads();
    if (hh == 0) {
#pragma unroll
      for (int q = 0; q < 4; ++q) {
        u32x4 w;
        w[0] = __float_as_uint(top[4 * q]); w[1] = __float_as_uint(top[4 * q + 1]); w[2] = __float_as_uint(top[4 * q + 2]); w[3] = __float_as_uint(top[4 * q + 3]);
        *(u32x4*)(sL + (jh * 64 + pr) * 16 + 4 * q) = w;
      }
    }
    __syncthreads();
    const int pair = tid >> 2, sub = tid & 3;
    const unsigned* l1 = sL + pair * 16;
    const unsigned* l2 = sL + (64 + pair) * 16;
    float v2[16];
#pragma unroll
    for (int q = 0; q < 4; ++q) {
      const u32x4 w = *(const u32x4*)(l2 + 4 * q);
      v2[4 * q] = __uint_as_float(w[0] & ~127u); v2[4 * q + 1] = __uint_as_float(w[1] & ~127u);
      v2[4 * q + 2] = __uint_as_float(w[2] & ~127u); v2[4 * q + 3] = __uint_as_float(w[3] & ~127u);
    }
    const float va0 = __uint_as_float(l1[sub] & ~127u), va1 = __uint_as_float(l1[4 + sub] & ~127u);
    const float va2 = __uint_as_float(l1[8 + sub] & ~127u), va3 = __uint_as_float(l1[12 + sub] & ~127u);
    const unsigned sc = (unsigned)sub << 4;
    float c[16], X[8];
#pragma unroll
    for (int b = 0; b < 16; ++b) c[b] = packc(va0 + v2[b], sc | (unsigned)b);
#pragma unroll
    for (int b = 0; b < 4; ++b) X[b] = packc(va1 + v2[b], sc | (unsigned)(64 + b));
    X[4] = packc(va2 + v2[0], sc | 128u); X[5] = packc(va2 + v2[1], sc | 129u);
    X[6] = packc(va3 + v2[0], sc | 192u); X[7] = -3.0e38f;
    bitonic_sort_desc<8>(X);
#pragma unroll
    for (int i = 8; i < 16; ++i) c[i] = fmaxf(c[i], X[15 - i]);
    bitonic_merge16_desc(c);
    merge_top16_xlane(c, 1);
    merge_top16_xlane(c, 2);
    const float mx = __uint_as_float(__float_as_uint(c[0]) & ~255u);
    float w[16]; int ex[16]; float sum = 0.f;
#pragma unroll
    for (int i = 0; i < 16; ++i) {
      const unsigned bits = __float_as_uint(c[i]);
      const int code = bits & 255, a = code >> 4, b = code & 15;
      ex[i] = (int)(l1[a] & 127u) * 128 + (int)(l2[b] & 127u);
      w[i] = __expf(__uint_as_float(bits & ~255u) - mx);
      sum += w[i];
    }
    const float inv = 1.0f / sum;
    const size_t o = ((size_t)tok0 * 8 + pair) * 16;
#pragma unroll
    for (int i = 0; i < 16; ++i)
      if ((i & 3) == sub) { IDX[o + i] = (u16)ex[i]; GATE[o + i] = w[i] * inv; }
  }
}

typedef __attribute__((ext_vector_type(2))) float f32x2;
typedef __attribute__((ext_vector_type(2))) _Float16 h16x2;
__device__ __forceinline__ int idx_of(const u32x4& lo, const u32x4& hi, int k) {
  const unsigned w = (k < 8) ? lo[(k & 7) >> 1] : hi[(k & 7) >> 1];
  return (k & 1) ? (int)(w >> 16) : (int)(w & 0xffffu);
}
typedef __attribute__((ext_vector_type(2))) __bf16 bf16x2v;
__device__ __forceinline__ int dot32_i4(const u32x4& v, const int (&t8)[8]) {
  int a = 0;
#pragma unroll
  for (int q = 0; q < 4; ++q) {
    a = __builtin_amdgcn_sdot4((int)(v[q] & 0x0f0f0f0fu), t8[2 * q], a, false);
    a = __builtin_amdgcn_sdot4((int)((v[q] >> 4) & 0x0f0f0f0fu), t8[2 * q + 1], a, false);
  }
  return a;
}
__device__ __forceinline__ bf16x2v bfpair_of(unsigned wd) { asm volatile("" : "+v"(wd)); return __builtin_bit_cast(bf16x2v, wd); }
__device__ __forceinline__ void phase12a(KP kp, int layer) {
  unsigned char* ws = kp->ws;
  const int tid = tidx(), lane = tid & 63, wave = tid >> 6, m = lane & 7, j = lane >> 3;
  const int bid = bidx();
  const int c = bid & 3;
  const int wsl = (bid >> 2) * 4 + wave, nwsl = (gridDim.x >> 2) * 4;
  const int mrows = (layer == 0) ? MTOT : NLAT;
  const unsigned char* H8 = (const unsigned char*)(ws + OFF_H8) + (size_t)(c * 8 + m) * MTOT * 32;
  const float* TS = (const float*)(ws + OFF_TS);
  const unsigned char* U4 = (const unsigned char*)(ws + OFF_UB) + c * 128 + m * 16;
  const u16* IDX = (const u16*)(ws + OFF_IDX) + 16 * j;
  u16* PART = (u16*)(ws + OFF_QPEER) + (size_t)c * MTOT * 128;
  int n = wsl;
  if (n >= mrows) return;
  u32x4 va[8], vb[8], t4[2];
  auto step = [&](u32x4& IClo, u32x4& IChi, const u32x4& INlo, const u32x4& INhi) -> bool {
    const bool has1 = (n + nwsl < mrows);
    const int n1 = has1 ? n + nwsl : n;
    const int n2 = (n1 + nwsl < mrows) ? n1 + nwsl : n1;
#pragma unroll
    for (int k = 0; k < 8; ++k) vb[k] = *(const u32x4*)(U4 + (size_t)idx_of(IClo, IChi, 8 + k) * 512);
    IClo = *(const u32x4*)(IDX + (size_t)n2 * 128); IChi = *(const u32x4*)(IDX + (size_t)n2 * 128 + 8);
    int t8[8];
#pragma unroll
    for (int i = 0; i < 2; ++i)
#pragma unroll
      for (int q = 0; q < 4; ++q) { unsigned wd = t4[i][q]; asm volatile("" : "+v"(wd)); t8[4 * i + q] = (int)wd; }
    int st = 0;
#pragma unroll
    for (int q = 0; q < 8; ++q) st = __builtin_amdgcn_sdot4(t8[q], 0x01010101, st, false);
    const float tsc = TS[n] * (6.0f / 7.0f);
    float p[16];
#pragma unroll
    for (int k = 0; k < 8; ++k) p[k] = (float)(dot32_i4(va[k], t8) - 8 * st);
#pragma unroll
    for (int k = 0; k < 8; ++k) va[k] = *(const u32x4*)(U4 + (size_t)idx_of(INlo, INhi, k) * 512);
#pragma unroll
    for (int i = 0; i < 2; ++i) t4[i] = *(const u32x4*)(H8 + (size_t)n1 * 32 + 16 * i);
#pragma unroll
    for (int k = 0; k < 8; ++k) p[8 + k] = (float)(dot32_i4(vb[k], t8) - 8 * st);
    float q8[8], q4[4], q2[2];
#pragma unroll
    for (int i = 0; i < 8; ++i) { const float keep = (lane & 4) ? p[i + 8] : p[i]; const float send = (lane & 4) ? p[i] : p[i + 8]; q8[i] = keep + __shfl_xor(send, 4); }
#pragma unroll
    for (int i = 0; i < 4; ++i) { const float keep = (lane & 2) ? q8[i + 4] : q8[i]; const float send = (lane & 2) ? q8[i] : q8[i + 4]; q4[i] = keep + __shfl_xor(send, 2); }
#pragma unroll
    for (int i = 0; i < 2; ++i) { const float keep = (lane & 1) ? q4[i + 2] : q4[i]; const float send = (lane & 1) ? q4[i] : q4[i + 2]; q2[i] = keep + __shfl_xor(send, 1); }
    const int kb = ((lane & 4) ? 8 : 0) + ((lane & 2) ? 4 : 0) + ((lane & 1) ? 2 : 0);
    *(unsigned*)(PART + (size_t)n * 128 + 16 * j + kb) = pack2(q2[0] * tsc, q2[1] * tsc);
    n += nwsl;
    return has1;
  };
  const int nb = (n + nwsl < mrows) ? n + nwsl : n;
  u32x4 iAlo = *(const u32x4*)(IDX + (size_t)n * 128), iAhi = *(const u32x4*)(IDX + (size_t)n * 128 + 8);
  u32x4 iBlo = *(const u32x4*)(IDX + (size_t)nb * 128), iBhi = *(const u32x4*)(IDX + (size_t)nb * 128 + 8);
#pragma unroll
  for (int k = 0; k < 8; ++k) va[k] = *(const u32x4*)(U4 + (size_t)idx_of(iAlo, iAhi, k) * 512);
#pragma unroll
  for (int i = 0; i < 2; ++i) t4[i] = *(const u32x4*)(H8 + (size_t)n * 32 + 16 * i);
  for (;;) {
    if (!step(iAlo, iAhi, iBlo, iBhi)) break;
    if (!step(iBlo, iBhi, iAlo, iAhi)) break;
  }
}
__device__ __forceinline__ void phase12b(KP kp, int layer) {
  unsigned char* ws = kp->ws;
  const int gtid = bidx() * NT + tidx(), gn = gridDim.x * NT;
  const int mrows = (layer == 0) ? MTOT : NLAT;
  const u32x2* PART = (const u32x2*)(ws + OFF_QPEER);
  const f32x4* GATE = (const f32x4*)(ws + OFF_GATE);
  u32x4* W = (u32x4*)(ws + OFF_YG);
  for (int e = gtid; e < mrows * 32; e += gn) {
    f32x4 p[4];
#pragma unroll
    for (int c = 0; c < 4; ++c) {
      const u32x2 v = PART[(size_t)c * MTOT * 32 + e];
      p[c][0] = __uint_as_float(v[0] << 16); p[c][1] = __uint_as_float(v[0] & 0xffff0000u);
      p[c][2] = __uint_as_float(v[1] << 16); p[c][3] = __uint_as_float(v[1] & 0xffff0000u);
    }
    const f32x4 g = GATE[e];
    f32x4 o;
#pragma unroll
    for (int j = 0; j < 4; ++j) {
      const float s = (p[0][j] + p[1][j]) + (p[2][j] + p[3][j]);
      o[j] = g[j] * gelu_tanh(s * (1.0f / 64.0f));
    }
    u32x2 pk; pk[0] = pack2(o[0], o[1]); pk[1] = pack2(o[2], o[3]);
    u32x4 wp;
#pragma unroll
    for (int q = 0; q < 2; ++q) {
      const float lo = __uint_as_float(pk[q] << 16), hi = __uint_as_float(pk[q] & 0xffff0000u);
      wp[2 * q] = __builtin_bit_cast(unsigned, __builtin_amdgcn_cvt_pkrtz(lo, lo));
      wp[2 * q + 1] = __builtin_bit_cast(unsigned, __builtin_amdgcn_cvt_pkrtz(hi, hi));
    }
    W[e] = wp;
  }
}
__device__ __forceinline__ void fma32_fp4(const u32x4& v, const h16x2 w2, h16x2 (&hacc)[16]) {
#pragma unroll
  for (int q = 0; q < 4; ++q) {
    hacc[4 * q] = __builtin_amdgcn_cvt_scalef32_pk_f16_fp4(v[q], 1.0f, 0) * w2 + hacc[4 * q];
    hacc[4 * q + 1] = __builtin_amdgcn_cvt_scalef32_pk_f16_fp4(v[q], 1.0f, 1) * w2 + hacc[4 * q + 1];
    hacc[4 * q + 2] = __builtin_amdgcn_cvt_scalef32_pk_f16_fp4(v[q], 1.0f, 2) * w2 + hacc[4 * q + 2];
    hacc[4 * q + 3] = __builtin_amdgcn_cvt_scalef32_pk_f16_fp4(v[q], 1.0f, 3) * w2 + hacc[4 * q + 3];
  }
}
__device__ __forceinline__ h16x2 w2_of(unsigned wd) { asm volatile("" : "+v"(wd)); return __builtin_bit_cast(h16x2, wd); }
__device__ __forceinline__ void phase12c(KP kp, int layer, unsigned char* smem) {
  unsigned char* ws = kp->ws;
  const int tid = tidx(), lane = tid & 63, wave = tid >> 6, m = lane & 7, g = lane >> 3;
  const int bid = bidx();
  const int c = bid & 3;
  const int wsl = (bid >> 2) * 4 + wave, nwsl = (gridDim.x >> 2) * 4;
  const int mrows = (layer == 0) ? MTOT : NLAT;
  const int ngrp = mrows >> 3;
  const unsigned char* V4 = (const unsigned char*)(ws + OFF_VB) + c * 128 + m * 16;
  const u16* IDX = (const u16*)(ws + OFF_IDX) + (size_t)g * 128;
  const unsigned* W = (const unsigned*)(ws + OFF_YG) + (size_t)g * 128;
  float* sG = (float*)smem;
  __syncthreads();
  for (int i = tid; i < 9 * 256; i += NT)
    sG[i] = ((const float*)(ws + OFF_MOD))[(size_t)layer * 9 * 6144 + (size_t)(i >> 8) * 6144 + 5120 + c * 256 + (i & 255)];
  __syncthreads();
  if (wsl >= ngrp) return;
  auto soff = [&](int G, int h) { return (size_t)G * 1024 + (size_t)(h * 16); };
  u32x4 va[8], vb[8];
  h16x2 hacc[16];
#pragma unroll
  for (int q = 0; q < 16; ++q) hacc[q] = (h16x2){(_Float16)0.f, (_Float16)0.f};
  int G0 = wsl, h0 = 0;
  auto step = [&](u32x4& IClo, u32x4& IChi, const u32x4& INlo, const u32x4& INhi, const u32x4 (&WC)[4], u32x4 (&WN)[4]) -> bool {
    const int G1 = (h0 < 7) ? G0 : G0 + nwsl, h1 = (h0 < 7) ? h0 + 1 : 0;
    const bool has1 = (G1 < ngrp);
    const int G1c = has1 ? G1 : G0, h1c = has1 ? h1 : h0;
    const int G2 = (h1c < 7) ? G1c : G1c + nwsl, h2 = (h1c < 7) ? h1c + 1 : 0;
    const bool has2 = has1 && (G2 < ngrp);
    const int G2c = has2 ? G2 : G1c, h2c = has2 ? h2 : h1c;
    const bool last_head = (h0 == 7);
#pragma unroll
    for (int k = 0; k < 8; ++k) vb[k] = *(const u32x4*)(V4 + (size_t)idx_of(IClo, IChi, 8 + k) * 512);
    IClo = *(const u32x4*)(IDX + soff(G2c, h2c)); IChi = *(const u32x4*)(IDX + soff(G2c, h2c) + 8);
    const int n = 8 * G0 + g;
    const bool is_lat = n < NLAT;
    float* xr = (is_lat ? (kp->out + (size_t)n * 1024) : ((float*)(ws + OFF_XC) + (size_t)(n - NLAT) * 1024)) + c * 256 + 4 * m;
    const float* gp = sG + (is_lat ? (n >> 12) : 8) * 256 + 4 * m;
    f32x4 x1[8];
    if (last_head) {
#pragma unroll
      for (int r = 0; r < 8; ++r) x1[r] = *(const f32x4*)(xr + 32 * r);
    }
#pragma unroll
    for (int k = 0; k < 8; ++k) fma32_fp4(va[k], w2_of(WC[k >> 2][k & 3]), hacc);
#pragma unroll
    for (int k = 0; k < 8; ++k) va[k] = *(const u32x4*)(V4 + (size_t)idx_of(INlo, INhi, k) * 512);
#pragma unroll
    for (int q = 0; q < 4; ++q) WN[q] = *(const u32x4*)(W + soff(G1c, h1c) + 4 * q);
#pragma unroll
    for (int k = 0; k < 8; ++k) fma32_fp4(vb[k], w2_of(WC[2 + (k >> 2)][k & 3]), hacc);
    if (last_head) {
#pragma unroll
      for (int r = 0; r < 8; ++r) {
        const f32x4 g2 = *(const f32x4*)(gp + 32 * r);
        f32x4 o;
        o[0] = x1[r][0] + g2[0] * (0.5f * (float)hacc[2 * r][0]); o[1] = x1[r][1] + g2[1] * (0.5f * (float)hacc[2 * r][1]);
        o[2] = x1[r][2] + g2[2] * (0.5f * (float)hacc[2 * r + 1][0]); o[3] = x1[r][3] + g2[3] * (0.5f * (float)hacc[2 * r + 1][1]);
        *(f32x4*)(xr + 32 * r) = o;
      }
#pragma unroll
      for (int q = 0; q < 16; ++q) hacc[q] = (h16x2){(_Float16)0.f, (_Float16)0.f};
    }
    G0 = G1; h0 = h1;
    return has1;
  };
  u32x4 iAlo = *(const u32x4*)(IDX + soff(G0, 0)), iAhi = *(const u32x4*)(IDX + soff(G0, 0) + 8);
  u32x4 iBlo = *(const u32x4*)(IDX + soff(G0, 1)), iBhi = *(const u32x4*)(IDX + soff(G0, 1) + 8);
#pragma unroll
  for (int k = 0; k < 8; ++k) va[k] = *(const u32x4*)(V4 + (size_t)idx_of(iAlo, iAhi, k) * 512);
  u32x4 wA[4], wB[4];
#pragma unroll
  for (int q = 0; q < 4; ++q) wA[q] = *(const u32x4*)(W + soff(G0, 0) + 4 * q);
  for (;;) {
    if (!step(iAlo, iAhi, iBlo, iBhi, wA, wB)) break;
    if (!step(iBlo, iBhi, iAlo, iAhi, wB, wA)) break;
  }
}
__device__ __forceinline__ void phase13(KP kp) {
  const int lane = tidx() & 63;
  const int gw = (bidx() * NT + tidx()) >> 6, nw = (gridDim.x * NT) >> 6;
  const float* fg = kp->in[I_FNG];
  for (int r0 = gw; r0 < NLAT; r0 += 2 * nw) {
    f32x4 v[2][4];
#pragma unroll
    for (int u = 0; u < 2; ++u) {
      const int r = (r0 + u * nw < NLAT) ? (r0 + u * nw) : r0;
      const float* row = kp->out + (size_t)r * 1024;
#pragma unroll
      for (int i = 0; i < 4; ++i) v[u][i] = *(const f32x4*)(row + i * 256 + lane * 4);
    }
#pragma unroll
    for (int u = 0; u < 2; ++u) {
      const int r = r0 + u * nw;
      if (r >= NLAT) break;
      float* row = kp->out + (size_t)r * 1024;
      float ss = 0.f;
#pragma unroll
      for (int i = 0; i < 4; ++i) ss += v[u][i][0] * v[u][i][0] + v[u][i][1] * v[u][i][1] + v[u][i][2] * v[u][i][2] + v[u][i][3] * v[u][i][3];
      ss = wave_sum(ss);
      const float rstd = rsqrtf(ss * (1.0f / 1024.0f) + EPSN);
#pragma unroll
      for (int i = 0; i < 4; ++i) {
        const f32x4 g = *(const f32x4*)(fg + i * 256 + lane * 4);
        f32x4 o; o[0] = v[u][i][0] * rstd * g[0]; o[1] = v[u][i][1] * rstd * g[1]; o[2] = v[u][i][2] * rstd * g[2]; o[3] = v[u][i][3] * rstd * g[3];
        *(f32x4*)(row + i * 256 + lane * 4) = o;
      }
    }
  }
}

#if PEER_OLD
__device__ __forceinline__ float dot8(u32x4 a, u32x4 b, float acc) {
  asm volatile("v_dot2c_f32_bf16 %0, %1, %5\n\tv_dot2c_f32_bf16 %0, %2, %6\n\tv_dot2c_f32_bf16 %0, %3, %7\n\tv_dot2c_f32_bf16 %0, %4, %8\n\ts_nop 3"
               : "+v"(acc) : "v"(a.x), "v"(a.y), "v"(a.z), "v"(a.w), "v"(b.x), "v"(b.y), "v"(b.z), "v"(b.w));
  return acc;
}
__device__ __forceinline__ void phase12(KP kp, int layer, bool dry = false) {
  unsigned char* ws = kp->ws;
  const int lane = tidx() & 63;
  const int gw = (bidx() * NT + tidx()) >> 6, nw = (gridDim.x * NT) >> 6;
  const int mrows = (layer == 0) ? MTOT : NLAT;
  const bool last = (layer == 1);
  const u16* H = (const u16*)(ws + OFF_H);
  const u16* UB = (const u16*)(ws + OFF_UB);
  const u16* VB = (const u16*)(ws + OFF_VB);
  const int* IDX = (const int*)(ws + OFF_IDX);
  const float* GATE = (const float*)(ws + OFF_GATE);
  const float* modl = (const float*)(ws + OFF_MOD) + (size_t)layer * 9 * 6144;
  for (int tok = gw; tok < mrows; tok += nw) {
    const u32x4 t0 = *(const u32x4*)(H + (size_t)tok * 1024 + lane * 8);
    const u32x4 t1 = *(const u32x4*)(H + (size_t)tok * 1024 + 512 + lane * 8);
    const int ia = IDX[(size_t)tok * 128 + lane], ib = IDX[(size_t)tok * 128 + 64 + lane];
    const float ga = GATE[(size_t)tok * 128 + lane], gb = GATE[(size_t)tok * 128 + 64 + lane];
#if PEER_SIMPLE
    float acc[16];
#pragma unroll
    for (int i = 0; i < 16; ++i) acc[i] = 0.f;
#pragma unroll 1
    for (int s = 0; s < 128; ++s) {
      const int e = __builtin_amdgcn_readlane((s < 64) ? ia : ib, s & 63);
      const float gt = __uint_as_float(__builtin_amdgcn_readlane(__float_as_uint((s < 64) ? ga : gb), s & 63));
      const u16* ur = UB + (size_t)e * 1024;
      const u32x4 ua = *(const u32x4*)(ur + lane * 8);
      const u32x4 ub = *(const u32x4*)(ur + 512 + lane * 8);
      float d = dot8(ub, t1, dot8(ua, t0, 0.f));
      d = wave_sum(d);
      const float wgt = gt * gelu_tanh(d);
      const u16* vr = VB + (size_t)e * 1024;
      const u32x4 a = *(const u32x4*)(vr + lane * 8);
      const u32x4 b = *(const u32x4*)(vr + 512 + lane * 8);
#pragma unroll
      for (int q = 0; q < 4; ++q) {
        acc[2 * q] += wgt * __uint_as_float(a[q] << 16);
        acc[2 * q + 1] += wgt * __uint_as_float(a[q] & 0xffff0000u);
        acc[8 + 2 * q] += wgt * __uint_as_float(b[q] << 16);
        acc[8 + 2 * q + 1] += wgt * __uint_as_float(b[q] & 0xffff0000u);
      }
    }
#else
    float wlo = 0.f, whi = 0.f;
#pragma unroll 1
    for (int bt = 0; bt < 16; ++bt) {
      const int iv = (bt < 8) ? ia : ib;
      const float gv = (bt < 8) ? ga : gb;
      const int sb = (bt & 7) * 8;
      float part[8];
#pragma unroll
      for (int s = 0; s < 8; ++s) {
        const int e = __builtin_amdgcn_readlane(iv, sb + s);
        const u16* ur = UB + (size_t)e * 1024;
        const u32x4 a = *(const u32x4*)(ur + lane * 8);
        const u32x4 b = *(const u32x4*)(ur + 512 + lane * 8);
        part[s] = dot8(b, t1, dot8(a, t0, 0.f));
      }
      float p4[4], p2[2];
#pragma unroll
      for (int i = 0; i < 4; ++i) {
        const float keep = (lane & 32) ? part[i + 4] : part[i];
        const float send = (lane & 32) ? part[i] : part[i + 4];
        p4[i] = keep + __shfl_xor(send, 32);
      }
#pragma unroll
      for (int i = 0; i < 2; ++i) {
        const float keep = (lane & 16) ? p4[i + 2] : p4[i];
        const float send = (lane & 16) ? p4[i] : p4[i + 2];
        p2[i] = keep + __shfl_xor(send, 16);
      }
      float tot;
      {
        const float keep = (lane & 8) ? p2[1] : p2[0];
        const float send = (lane & 8) ? p2[0] : p2[1];
        tot = keep + __shfl_xor(send, 8);
      }
      tot += __shfl_xor(tot, 4);
      tot += __shfl_xor(tot, 2);
      tot += __shfl_xor(tot, 1);
      const float act = gelu_tanh(tot);
      const float mine = __shfl(act, (lane & 7) * 8);
      const bool sel = ((lane >> 3) == (bt & 7));
      if (bt < 8) wlo = sel ? mine * gv : wlo; else whi = sel ? mine * gv : whi;
    }
    float acc[16];
#pragma unroll
    for (int i = 0; i < 16; ++i) acc[i] = 0.f;
#pragma unroll 1
    for (int hf = 0; hf < 2; ++hf) {
      const int iv = hf ? ib : ia;
      const float wv = hf ? whi : wlo;
#pragma unroll 8
      for (int s = 0; s < 64; ++s) {
        const int e = __builtin_amdgcn_readlane(iv, s);
        const float wgt = __uint_as_float(__builtin_amdgcn_readlane(__float_as_uint(wv), s));
        const u16* vr = VB + (size_t)e * 1024;
        const u32x4 a = *(const u32x4*)(vr + lane * 8);
        const u32x4 b = *(const u32x4*)(vr + 512 + lane * 8);
#pragma unroll
        for (int q = 0; q < 4; ++q) {
          acc[2 * q] += wgt * __uint_as_float(a[q] << 16);
          acc[2 * q + 1] += wgt * __uint_as_float(a[q] & 0xffff0000u);
          acc[8 + 2 * q] += wgt * __uint_as_float(b[q] << 16);
          acc[8 + 2 * q + 1] += wgt * __uint_as_float(b[q] & 0xffff0000u);
        }
      }
    }
#endif
    const bool is_lat = tok < NLAT;
    const int bb = is_lat ? (tok >> 12) : 8;
    float* xr = is_lat ? (kp->out + (size_t)tok * 1024) : ((float*)(ws + OFF_XC) + (size_t)(tok - NLAT) * 1024);
    const float* g2 = modl + (size_t)bb * 6144 + 5120;
    float x2[16];
    float ss = 0.f;
#pragma unroll
    for (int hq = 0; hq < 2; ++hq) {
      const int c0 = hq * 512 + lane * 8;
      const f32x4 xa = *(const f32x4*)(xr + c0), xb = *(const f32x4*)(xr + c0 + 4);
      const f32x4 g2a = *(const f32x4*)(g2 + c0), g2b = *(const f32x4*)(g2 + c0 + 4);
#pragma unroll
      for (int j = 0; j < 4; ++j) {
        x2[hq * 8 + j] = xa[j] + g2a[j] * acc[hq * 8 + j];
        x2[hq * 8 + 4 + j] = xb[j] + g2b[j] * acc[hq * 8 + 4 + j];
      }
    }
    if (last) {
#pragma unroll
      for (int i = 0; i < 16; ++i) ss += x2[i] * x2[i];
      ss = wave_sum(ss);
      const float rstd = rsqrtf(ss * (1.0f / 1024.0f) + EPSN);
      const float* fg = kp->in[I_FNG];
#pragma unroll
      for (int hq = 0; hq < 2; ++hq) {
        const int c0 = hq * 512 + lane * 8;
        const f32x4 fa = *(const f32x4*)(fg + c0), fb = *(const f32x4*)(fg + c0 + 4);
#pragma unroll
        for (int j = 0; j < 4; ++j) { x2[hq * 8 + j] *= rstd * fa[j]; x2[hq * 8 + 4 + j] *= rstd * fb[j]; }
      }
    }
#pragma unroll
    for (int hq = 0; hq < 2; ++hq) {
      const int c0 = hq * 512 + lane * 8;
      f32x4 oa, ob;
#pragma unroll
      for (int j = 0; j < 4; ++j) { oa[j] = x2[hq * 8 + j]; ob[j] = x2[hq * 8 + 4 + j]; }
      float* xw = dry ? ((float*)(ws + OFF_QPEER) + (size_t)tok * 1024) : xr;
      *(f32x4*)(xw + c0) = oa;
      *(f32x4*)(xw + c0 + 4) = ob;
    }
  }
}

#endif

#if DEBUG_CHECKS
constexpr size_t OFF_CHK = WS_TOTAL;
constexpr size_t OFF_CHKBUF = WS_TOTAL + 256;
constexpr size_t WS_TOTAL_DBG = OFF_CHKBUF + 64 * 1024 * 4;
__device__ __forceinline__ unsigned hashu(unsigned x) { x ^= x >> 16; x *= 0x7feb352du; x ^= x >> 15; x *= 0x846ca68bu; x ^= x >> 16; return x; }
__device__ __forceinline__ void chk_rep(KP kp, int id, float fast, float ref, float floorv) {
  float err = fabsf(fast - ref) / fmaxf(fabsf(ref), floorv);
  if (!(err == err)) err = 1e9f;
  atomicMax((unsigned*)(kp->ws + OFF_CHK) + id, __float_as_uint(err));
}
__device__ __forceinline__ float rope_ref(float x_self, float x_partner, bool first_half, int pos, int i, int half) {
  const float invf = __powf(10000.0f, -(float)i / (float)half);
  const float ang = (float)pos * invf;
  const float c = __cosf(ang), s = __sinf(ang);
  return first_half ? (x_self * c - x_partner * s) : (x_partner * s + x_self * c);
}
__device__ __forceinline__ void chk_mod(KP kp) {
  const int gt = bidx() * NT + tidx();
  if (gt >= 1024) return;
  const unsigned h = hashu(gt * 7919u + 13u);
  const int l = gt & 1, b = (gt >> 1) % 9, n = h % 6144;
  float v = kp->in[I_BADA][l * 6144 + n];
  for (int k = 0; k < 1024; ++k) {
    const float c = (b < 8) ? kp->in[I_C][b * 1024 + k] : kp->in[I_CCTX][k];
    v += (c / (1.0f + __expf(-c))) * kp->in[I_WADA][(size_t)l * 1024 * 6144 + (size_t)k * 6144 + n];
  }
  chk_rep(kp, 0, ((const float*)(kp->ws + OFF_MOD))[(l * 9 + b) * 6144 + n], v, 0.05f);
}
__device__ __forceinline__ void chk_norm(KP kp, int layer, int id, const float* src_lat, const float* src_ctx, const float* g, int sh_off, int sc_off, int nrows) {
  const int gt = bidx() * NT + tidx();
  if (gt >= 2048) return;
  const unsigned h = hashu(gt * 31u + 7u + id * 1000u);
  const int r = h % nrows, c = (h >> 16) % 1024;
  const float* src = (r < NLAT) ? src_lat + (size_t)r * 1024 : src_ctx + (size_t)(r - NLAT) * 1024;
  float ss = 0.f;
  for (int k = 0; k < 1024; ++k) ss += src[k] * src[k];
  const float rstd = rsqrtf(ss / 1024.0f + EPSN);
  const int bb = (r < NLAT) ? (r >> 12) : 8;
  const float* m = (const float*)(kp->ws + OFF_MOD) + (size_t)(layer * 9 + bb) * 6144;
  const float ref = src[c] * rstd * g[c] * (1.0f + m[sc_off + c]) + m[sh_off + c];
  chk_rep(kp, id, bf2f(((const u16*)(kp->ws + OFF_H))[(size_t)r * 1024 + c]), ref, 0.1f);
}
__device__ __forceinline__ float zproj(KP kp, int layer, int r, int n) {
  const u16* H = (const u16*)(kp->ws + OFF_H) + (size_t)r * 1024;
  const float* w = kp->in[I_WIN] + (size_t)layer * 1024 * 1888 + n;
  float z = 0.f;
  for (int k = 0; k < 1024; ++k) z += bf2f(H[k]) * w[(size_t)k * 1888];
  return z;
}
__device__ __forceinline__ void chk_proj(KP kp, int layer) {
  const int gt = bidx() * NT + tidx();
  if (gt >= 4096) return;
  unsigned char* ws = kp->ws;
  const unsigned h = hashu(gt * 2654435761u + 99u);
  const int r = (gt & 7) == 0 ? (NLAT + (h % NCTX)) : (h % NLAT);
  const int n = (h >> 12) % 1888;
  int b, tk; row_btk(r, b, tk);
  const bool lat = r < NLAT;
  const int rowp = tk >> 6, colp = tk & 63;
  float ref, fast;
  const float z = zproj(kp, layer, r, n);
  if (n < 384 || (n >= 1120 && n < 1632)) {
    int seg0, nh; const u16* base; float scale = 1.0f; bool rope = false;
    if (n < 256) { seg0 = 0; nh = 4; base = (const u16*)(ws + OFF_QA); scale = 0.125f * LOG2E; rope = lat; }
    else if (n < 384) { seg0 = 256; nh = 2; base = (const u16*)(ws + OFF_KA); rope = lat; }
    else if (n < 1376) { seg0 = 1120; nh = 4; base = (const u16*)(ws + OFF_QD); scale = 0.125f * LOG2E; }
    else { seg0 = 1376; nh = 4; base = (const u16*)(ws + OFF_KD); }
    const int head = (n - seg0) >> 6, d = (n - seg0) & 63;
    float v = z;
    if (rope) {
      const int dd = d & 31, i = dd & 15; const bool fh = dd < 16;
      const float zp = zproj(kp, layer, r, fh ? n + 16 : n - 16);
      v = rope_ref(z, zp, fh, (d < 32) ? rowp : colp, i, 16);
    }
    ref = v * scale;
    fast = bf2f(base[((size_t)(b * nh + head) * LK + tk) * 64 + d]);
  } else if ((n >= 384 && n < 512) || n >= 1632) {
    int seg0, nh; const u16* base;
    if (n < 512) { seg0 = 384; nh = 2; base = (const u16*)(ws + OFF_VTA); } else { seg0 = 1632; nh = 4; base = (const u16*)(ws + OFF_VTD); }
    const int head = (n - seg0) >> 6, d = (n - seg0) & 63;
    ref = z; fast = bf2f(base[((size_t)(b * nh + head) * 64 + d) * LK + tk]);
  } else if (n < 704) { ref = z; fast = bf2f(((const u16*)(ws + OFF_CQ))[(size_t)r * 192 + n - 512]); }
  else if (n < 832) { ref = z; fast = bf2f(((const u16*)(ws + OFF_CKV))[(size_t)r * 128 + n - 704]); }
  else if (n < 864) {
    const int d = n - 832; float v = z;
    if (lat) { const int dd = d & 15, i = dd & 7; const bool fh = dd < 8; const float zp = zproj(kp, layer, r, fh ? n + 8 : n - 8); v = rope_ref(z, zp, fh, (d < 16) ? rowp : colp, i, 8); }
    ref = v; fast = bf2f(((const u16*)(ws + OFF_KB))[((size_t)(b * 4 + (h & 3)) * LK + tk) * 96 + 64 + d]);
  } else { ref = z; fast = bf2f(((const u16*)(ws + OFF_U5))[(size_t)r * 256 + n - 864]); }
  chk_rep(kp, 2, fast, ref, 0.15f);
}
__device__ __forceinline__ void chk_mla(KP kp, int layer) {
  const int gt = bidx() * NT + tidx();
  if (gt >= 2048) return;
  unsigned char* ws = kp->ws;
  const unsigned h = hashu(gt * 40503u + 5u);
  const int r = (gt & 7) == 0 ? (NLAT + (h % NCTX)) : (h % NLAT);
  int b, tk; row_btk(r, b, tk);
  const bool lat = r < NLAT;
  if (gt & 1) {
    const int col = (h >> 13) % 384, head = col / 96, dd = col % 96;
    const u16* cq = (const u16*)(ws + OFF_CQ) + (size_t)r * 192;
    float ss = 0.f; for (int k = 0; k < 192; ++k) ss += bf2f(cq[k]) * bf2f(cq[k]);
    const float rstd = rsqrtf(ss / 192.0f + EPSN);
    auto qv = [&](int c) { float a = 0.f; for (int k = 0; k < 192; ++k) a += bf2f(cq[k]) * rstd * kp->in[I_QNG][layer * 192 + k] * kp->in[I_WUQ][(size_t)layer * 192 * 384 + (size_t)k * 384 + c]; return a; };
    float v = qv(col);
    if (dd >= 64 && lat) { const int e = dd - 64, d8 = e & 15, i = d8 & 7; const bool fh = d8 < 8; const float vp = qv(fh ? col + 8 : col - 8); v = rope_ref(v, vp, fh, (e < 16) ? (tk >> 6) : (tk & 63), i, 8); }
    chk_rep(kp, 3, bf2f(((const u16*)(ws + OFF_QB))[((size_t)(b * 4 + head) * LK + tk) * 96 + dd]), v * 0.10206207261596575f * LOG2E, 0.1f);
  } else {
    const int col = (h >> 13) % 512, head = col / 128, w = col % 128;
    const u16* ck = (const u16*)(ws + OFF_CKV) + (size_t)r * 128;
    float ss = 0.f; for (int k = 0; k < 128; ++k) ss += bf2f(ck[k]) * bf2f(ck[k]);
    const float rstd = rsqrtf(ss / 128.0f + EPSN);
    float a = 0.f; for (int k = 0; k < 128; ++k) a += bf2f(ck[k]) * rstd * kp->in[I_KVNG][layer * 128 + k] * kp->in[I_WUKV][(size_t)layer * 128 * 512 + (size_t)k * 512 + col];
    const float fast = (w < 64) ? bf2f(((const u16*)(ws + OFF_KB))[((size_t)(b * 4 + head) * LK + tk) * 96 + w])
                                : bf2f(((const u16*)(ws + OFF_VTB))[((size_t)(b * 4 + head) * 64 + (w - 64)) * LK + tk]);
    chk_rep(kp, 3, fast, a, 0.15f);
  }
}
__device__ __forceinline__ void chk_attn(KP kp, int layer) {
  unsigned char* ws = kp->ws;
  const int lane = tidx() & 63;
  const int gw = (bidx() * NT + tidx()) >> 6, nw = (gridDim.x * NT) >> 6;
  for (int s = gw; s < 768; s += nw) {
    const unsigned h = hashu(s * 977u + 3u);
    const int mixer = s % 3;
    const bool ctxq = (layer == 0) && ((s & 15) == 3);
    const int b = (h >> 3) & 7, head = (h >> 6) & 3, dv = (h >> 8) & 63;
    const int tq = ctxq ? (4096 + ((h >> 14) & 255)) : ((h >> 14) & 4095);
    const int DK = (mixer == 1) ? 96 : 64;
    const u16 *Q, *K, *VT; int ycol; int kvh = head, nkv = 4;
    if (mixer == 0) { Q = (const u16*)(ws + OFF_QA); K = (const u16*)(ws + OFF_KA); VT = (const u16*)(ws + OFF_VTA); ycol = 0; kvh = head >> 1; nkv = 2; }
    else if (mixer == 1) { Q = (const u16*)(ws + OFF_QB); K = (const u16*)(ws + OFF_KB); VT = (const u16*)(ws + OFF_VTB); ycol = 256; }
    else { Q = (const u16*)(ws + OFF_QD); K = (const u16*)(ws + OFF_KD); VT = (const u16*)(ws + OFF_VTD); ycol = 768; }
    const u16* q = Q + ((size_t)(b * 4 + head) * LK + tq) * DK;
    const u16* Kb = K + (size_t)(b * nkv + kvh) * LK * DK;
    const u16* Vb = VT + ((size_t)(b * nkv + kvh) * 64 + dv) * LK;
    const int qr = tq >> 6, qc = tq & 63;
    int r0 = qr - 4; r0 = r0 < 0 ? 0 : (r0 > 56 ? 56 : r0);
    int cs = qc - 8; cs = cs < 0 ? 0 : (cs > 48 ? 48 : cs);
    float mx = -1e30f;
    for (int pass = 0; pass < 2; ++pass) {
      float num = 0.f, den = 0.f;
      for (int k = lane; k < LK; k += 64) {
        bool valid; float bias = 0.f;
        if (k >= 4096) valid = true;
        else if (ctxq) valid = false;
        else if (mixer == 0) { const int d = tq - k; valid = (d <= 128 && d >= -128); }
        else if (mixer == 1) valid = true;
        else { const int kr = k >> 6, kc = k & 63; valid = (kr >= r0 && kr < r0 + 8 && kc >= cs && kc < cs + 16);
               if (valid) bias = kp->in[I_RPB][((size_t)(layer * 4 + head) * 15 + (kr - qr + 7)) * 31 + (kc - qc + 15)] * LOG2E; }
        if (!valid) continue;
        float sc = 0.f;
        for (int d = 0; d < DK; ++d) sc += bf2f(q[d]) * bf2f(Kb[(size_t)k * DK + d]);
        sc += bias;
        if (pass == 0) mx = fmaxf(mx, sc);
        else { const float pr = exp2f(sc - mx); den += pr; num += pr * bf2f(Vb[k]); }
      }
      if (pass == 0) { for (int o = 32; o >= 1; o >>= 1) mx = fmaxf(mx, __shfl_xor(mx, o)); }
      else {
        num = wave_sum(num); den = wave_sum(den);
        if (mixer == 0) den += exp2f(kp->in[I_SINK][layer * 4 + head] * LOG2E - mx);
        const int orow = ctxq ? (NLAT + b * 256 + (tq - 4096)) : (b * 4096 + tq);
        if (lane == 0) chk_rep(kp, 4 + mixer, bf2f(((const u16*)(ws + OFF_H))[(size_t)orow * 1024 + ycol + head * 64 + dv]), num / den, 0.02f);
      }
    }
  }
}
__device__ __forceinline__ void chk_s5(KP kp, int layer, unsigned char* smem) {
  unsigned char* ws = kp->ws;
  if (bidx() >= 8) return;
  const int tid = tidx();
  const unsigned h = hashu(bidx() * 131u + 17u + layer);
  const int b = h & 7, g = (h >> 3) & 15;
  float* ys = (float*)smem;
  for (int i = tid; i < 68 * 16; i += NT) ys[i] = 0.f;
  __syncthreads();
  if (tid < 128) {
    const int dir = tid >> 6, p = tid & 63;
    const int i4 = ((layer * 2 + dir) * 16 + g) * 64 + p;
    const float lr = kp->in[I_LRE][i4], li = kp->in[I_LIM][i4], step = __expf(kp->in[I_LSTEP][(layer * 2 + dir) * 16 + g]);
    const float mag = __expf(lr * step), abr = mag * __cosf(li * step), abi = mag * __sinf(li * step);
    const float nr = abr - 1.0f, ni = abi, den = lr * lr + li * li;
    const float fr = (nr * lr + ni * li) / den, fi = (ni * lr - nr * li) / den;
    float bbr[16], bbi[16];
#pragma unroll
    for (int ch = 0; ch < 16; ++ch) { const float br = kp->in[I_BRE][(size_t)i4 * 16 + ch], bi = kp->in[I_BIM][(size_t)i4 * 16 + ch]; bbr[ch] = fr * br - fi * bi; bbi[ch] = fr * bi + fi * br; }
    float hr = 0.f, hi = 0.f;
    const u16* U5 = (const u16*)(ws + OFF_U5);
    for (int st = 0; st < 4352; ++st) {
      int row, posid;
      if (st < 256) { const int j = dir ? 255 - st : st; row = NLAT + b * 256 + j; posid = 4096 + j; }
      else { const int t = dir ? 4095 - (st - 256) : (st - 256); row = b * 4096 + t; posid = t; }
      float bur = 0.f, bui = 0.f;
#pragma unroll
      for (int ch = 0; ch < 16; ++ch) { const float u = bf2f(U5[(size_t)row * 256 + g * 16 + ch]); bur += bbr[ch] * u; bui += bbi[ch] * u; }
      const float nhr = abr * hr - abi * hi + bur, nhi = abr * hi + abi * hr + bui;
      hr = nhr; hi = nhi;
      if ((posid & 63) == 37) {
        const int sidx = posid >> 6;
        for (int cp = 0; cp < 16; ++cp) {
          const int ci = (((layer * 2 + dir) * 16 + g) * 16 + cp) * 64 + p;
          atomicAdd(&ys[sidx * 16 + cp], kp->in[I_CRE][ci] * hr - kp->in[I_CIM][ci] * hi);
        }
      }
    }
  }
  __syncthreads();
  for (int i = tid; i < 68 * 16; i += NT) {
    const int sidx = i >> 4, cp = i & 15;
    const int posid = sidx * 64 + 37;
    const int row = (posid < 4096) ? (b * 4096 + posid) : (NLAT + b * 256 + (posid - 4096));
    if (layer == 1 && posid >= 4096) continue;
    const float u = bf2f(((const u16*)(ws + OFF_U5))[(size_t)row * 256 + g * 16 + cp]);
    const float y = ys[i] + kp->in[I_S5D][layer * 256 + g * 16 + cp] * u;
    chk_rep(kp, 7, bf2f(((const u16*)(ws + OFF_YG))[(size_t)row * 256 + g * 16 + cp]), gelu_tanh(y), 0.05f);
  }
  __syncthreads();
}
__device__ __forceinline__ void chk_glu(KP kp, int layer) {
  const int gt = bidx() * NT + tidx();
  if (gt >= 2048) return;
  const unsigned h = hashu(gt * 7u + 1u);
  const int r = h % NLAT, c = (h >> 16) & 255;
  const u16* yg = (const u16*)(kp->ws + OFF_YG) + (size_t)r * 256;
  const float* w = kp->in[I_WGLU] + (size_t)layer * 256 * 512;
  float a = 0.f, gg = 0.f;
  for (int k = 0; k < 256; ++k) { a += bf2f(yg[k]) * w[k * 512 + c]; gg += bf2f(yg[k]) * w[k * 512 + 256 + c]; }
  chk_rep(kp, 8, bf2f(((const u16*)(kp->ws + OFF_H))[(size_t)r * 1024 + 512 + c]), a / (1.0f + __expf(-gg)), 0.05f);
}
__device__ __forceinline__ void chk_gn(KP kp) {
  const int gt = bidx() * NT + tidx();
  if (gt >= 2048) return;
  const unsigned h = hashu(gt * 13u + 2u);
  const int r = h % NLAT, grp = (h >> 20) & 3;
  const u16* y = (const u16*)(kp->ws + OFF_H) + (size_t)r * 1024 + grp * 256;
  float ss = 0.f; for (int k = 0; k < 256; ++k) ss += bf2f(y[k]) * bf2f(y[k]);
  chk_rep(kp, 9, ss / 256.0f, 1.0f, 1.0f);
}
__device__ __forceinline__ void chk_out(KP kp, int layer) {
  if (layer != 0) return;
  const int gt = bidx() * NT + tidx();
  if (gt >= 2048) return;
  const unsigned h = hashu(gt * 17u + 4u);
  const int r = (gt & 7) == 0 ? (NLAT + (h % NCTX)) : (h % NLAT), n = (h >> 16) & 1023;
  const u16* y = (const u16*)(kp->ws + OFF_H) + (size_t)r * 1024;
  float a = 0.f;
  for (int k = 0; k < 1024; ++k) a += bf2f(y[k]) * kp->in[I_MIXG][layer * 1024 + k] * kp->in[I_WOUT][(size_t)layer * 1024 * 1024 + (size_t)k * 1024 + n];
  const int bb = (r < NLAT) ? (r >> 12) : 8;
  const float g1 = ((const float*)(kp->ws + OFF_MOD))[(size_t)(layer * 9 + bb) * 6144 + 2048 + n];
  const float xin = (r < NLAT) ? kp->in[I_X][(size_t)r * 1024 + n] : kp->in[I_CTX][(size_t)(r - NLAT) * 1024 + n];
  const float fast = (r < NLAT) ? kp->out[(size_t)r * 1024 + n] : ((const float*)(kp->ws + OFF_XC))[(size_t)(r - NLAT) * 1024 + n];
  chk_rep(kp, 10, fast - xin, g1 * a, 0.05f);
}
__device__ __forceinline__ void chk_q(KP kp, int layer) {
  const int gt = bidx() * NT + tidx();
  if (gt >= 2048) return;
  const unsigned h = hashu(gt * 19u + 6u);
  const int r = h % NLAT, n = (h >> 16) & 2047;
  const u16* hh = (const u16*)(kp->ws + OFF_H) + (size_t)r * 1024;
  float a = 0.f;
  for (int k = 0; k < 1024; ++k) a += bf2f(hh[k]) * kp->in[I_PWQ][(size_t)layer * 1024 * 2048 + (size_t)k * 2048 + n];
  chk_rep(kp, 11, bf2f(((const u16*)(kp->ws + OFF_QPEER))[(size_t)r * 2048 + n]), a, 0.15f);
}
__device__ __forceinline__ void chk_topk(KP kp, int layer, unsigned char* smem) {
  const int tid = tidx();
  if (bidx() >= 16) return;
  float* s = (float*)smem;
  if (tid < 16) {
    const unsigned h = hashu((bidx() * 16 + tid) * 23u + 8u);
    const int r = h % NLAT, head = (h >> 16) & 7;
    float* s1 = s + tid * 1024; float* s2 = s1 + 128; float* cs_ = s1 + 256; int* ci_ = (int*)(s1 + 512);
    const u16* q = (const u16*)(kp->ws + OFF_QPEER) + (size_t)r * 2048 + head * 256;
    for (int k = 0; k < 128; ++k) {
      float a = 0.f, b2 = 0.f;
      for (int d = 0; d < 128; ++d) {
        a += bf2f(q[d]) * kp->in[I_SUBK][((size_t)(layer * 2 + 0) * 128 + k) * 128 + d];
        b2 += bf2f(q[128 + d]) * kp->in[I_SUBK][((size_t)(layer * 2 + 1) * 128 + k) * 128 + d];
      }
      s1[k] = a; s2[k] = b2;
    }
    float* v1 = s1 + 768; float* v2 = s1 + 784; int* i1 = (int*)(s1 + 800); int* i2 = (int*)(s1 + 816); float* tv = s1 + 832; int* te = (int*)(s1 + 848);
    for (int t = 0; t < 16; ++t) { int bi = 0; float bv = -3e38f; for (int k = 0; k < 128; ++k) if (s1[k] > bv) { bv = s1[k]; bi = k; } v1[t] = bv; i1[t] = bi; s1[bi] = -3e38f; }
    for (int t = 0; t < 16; ++t) { int bi = 0; float bv = -3e38f; for (int k = 0; k < 128; ++k) if (s2[k] > bv) { bv = s2[k]; bi = k; } v2[t] = bv; i2[t] = bi; s2[bi] = -3e38f; }
    for (int a = 0; a < 16; ++a) for (int b2 = 0; b2 < 16; ++b2) { cs_[a * 16 + b2] = v1[a] + v2[b2]; ci_[a * 16 + b2] = i1[a] * 128 + i2[b2]; }
    for (int t = 0; t < 16; ++t) { int bi = 0; float bv = -3e38f; for (int k = 0; k < 256; ++k) if (cs_[k] > bv) { bv = cs_[k]; bi = k; } tv[t] = bv; te[t] = ci_[bi]; cs_[bi] = -3e38f; }
    const float tmax = tv[0];
    float sum = 0.f; for (int t = 0; t < 16; ++t) { tv[t] = __expf(tv[t] - tmax); sum += tv[t]; }
    const u16* IDX = (const u16*)(kp->ws + OFF_IDX) + ((size_t)r * 8 + head) * 16;
    const float* GATE = (const float*)(kp->ws + OFF_GATE) + ((size_t)r * 8 + head) * 16;
    float err = 0.f;
    for (int t = 0; t < 16; ++t) {
      float gf = 0.f;
      for (int u = 0; u < 16; ++u) if (IDX[u] == te[t]) gf = GATE[u];
      err += fabsf(gf - tv[t] / sum);
    }
    chk_rep(kp, 12, err, 0.f, 1.0f);
  }
}
__device__ __forceinline__ void chk_peer_a(KP kp, int layer) {
  unsigned char* ws = kp->ws;
  const int lane = tidx() & 63;
  const int gw = (bidx() * NT + tidx()) >> 6;
  if (gw >= 64) return;
  {
    const unsigned hh = hashu((gw * 64 + lane) * 37u + 11u);
    const size_t ei = (size_t)(hh % (16384u * 1024u));
    chk_rep(kp, 15, bf2f(((const u16*)(ws + OFF_UB))[ei]), kp->in[I_PU][(size_t)layer * 16384 * 1024 + ei], 0.01f);
    chk_rep(kp, 16, bf2f(((const u16*)(ws + OFF_VB))[ei]), kp->in[I_PV][(size_t)layer * 16384 * 1024 + ei], 0.3f);
  }
  const int tok = hashu(gw * 29u + 9u + layer) % NLAT;
  const u16* hrow = (const u16*)(ws + OFF_H) + (size_t)tok * 1024;
  const u16* IDX = (const u16*)(ws + OFF_IDX) + (size_t)tok * 128;
  const float* GATE = (const float*)(ws + OFF_GATE) + (size_t)tok * 128;
  float acc[16];
  _Pragma("unroll") for (int i = 0; i < 16; ++i) acc[i] = 0.f;
  for (int s = 0; s < 128; ++s) {
    const int e = IDX[s];
    const float* ur = kp->in[I_PU] + ((size_t)layer * 16384 + e) * 1024;
    const float* vr = kp->in[I_PV] + ((size_t)layer * 16384 + e) * 1024;
    float d = 0.f;
    _Pragma("unroll") for (int i = 0; i < 16; ++i) d += bf2f(hrow[lane + 64 * i]) * ur[lane + 64 * i];
    d = wave_sum(d);
    const float w = GATE[s] * gelu_tanh(d);
    _Pragma("unroll") for (int i = 0; i < 16; ++i) acc[i] += w * vr[lane + 64 * i];
  }
  const float* g2 = (const float*)(ws + OFF_MOD) + (size_t)(layer * 9 + (tok >> 12)) * 6144 + 5120;
  float x2[16]; float ss = 0.f;
  _Pragma("unroll") for (int i = 0; i < 16; ++i) { x2[i] = kp->out[(size_t)tok * 1024 + lane + 64 * i] + g2[lane + 64 * i] * acc[i]; ss += x2[i] * x2[i]; }
  if (layer == 1) { ss = wave_sum(ss); const float rstd = rsqrtf(ss / 1024.0f + EPSN); _Pragma("unroll") for (int i = 0; i < 16; ++i) x2[i] *= rstd * kp->in[I_FNG][lane + 64 * i]; }
  float* cb = (float*)(ws + OFF_CHKBUF) + (size_t)gw * 1024;
  _Pragma("unroll") for (int i = 0; i < 16; ++i) cb[lane + 64 * i] = x2[i];
}
__device__ __forceinline__ void chk_peer_b(KP kp, int layer) {
  const int lane = tidx() & 63;
  const int gw = (bidx() * NT + tidx()) >> 6;
  if (gw >= 64) return;
  const int tok = hashu(gw * 29u + 9u + layer) % NLAT;
  const float* cb = (const float*)(kp->ws + OFF_CHKBUF) + (size_t)gw * 1024;
  _Pragma("unroll") for (int i = 0; i < 16; ++i) {
    const float fa = kp->out[(size_t)tok * 1024 + lane + 64 * i], rf = cb[lane + 64 * i];
    chk_rep(kp, 13, fa, rf, 0.3f);
    if (fabsf(fa - rf) > 0.03f) atomicAdd((float*)(kp->ws + OFF_CHK) + 17, 1.0f / 65536.0f);
  }
}
__device__ __forceinline__ void chk_final(KP kp) {
  const float* e = (const float*)(kp->ws + OFF_CHK);
  float v;
  if (DEBUG_ONE < 0) {
    int mask = 0;
    for (int i = 0; i < 6; ++i) { const float x = e[DEBUG_SEL * 6 + i]; if (!(x <= DEBUG_TOL)) mask |= (1 << i); }
    v = sqrtf((float)(1 + mask) * 100.0f);
  } else {
    v = sqrtf(1.0e4f * fminf(e[DEBUG_ONE], 1.0e6f));
  }
  const int gt = bidx() * NT + tidx(), gn = gridDim.x * NT;
  for (int i = gt; i < NLAT * 1024; i += gn) kp->out[i] = v;
}
#endif
__device__ __forceinline__ KP fresh_params() {
  KP kp = (KP)__builtin_amdgcn_kernarg_segment_ptr();
  asm volatile("" : "+s"(kp));
  return kp;
}
#define GS_CG() do { asm volatile("s_waitcnt vmcnt(0)" ::: "memory"); grid.sync(); __builtin_amdgcn_fence(__ATOMIC_ACQUIRE, "agent"); asm volatile("s_waitcnt vmcnt(0)" ::: "memory"); } while (0)
#define GS() xcd_barrier((unsigned*)(fresh_params()->ws + OFF_BAR), xb_st)
#if DEBUG_CHECKS
#define CHK(x) do { if (layer == DEBUG_LAYER) { x; GS(); } } while (0)
#else
#define CHK(x) do { } while (0)
#endif
__global__ void __launch_bounds__(NT, 2) mega_kernel(Params p_unused) {
  __shared__ __attribute__((aligned(16))) unsigned char smem[SMEM_BYTES];
  cg::grid_group grid = cg::this_grid();
  volatile LAS unsigned* xb_st = (volatile LAS unsigned*)(smem + SMEM_BYTES - 16);
  {
    unsigned* barp0 = (unsigned*)(fresh_params()->ws + OFF_BAR);
    if (threadIdx.x == 0) {
      xb_st[0] = 0u; xb_st[1] = 0u;
      (void)xb_add(barp0 + XB_XCNT(xb_xcc_id()), 1u);
    }
  }
  __syncthreads();
#if DEBUG_CHECKS
  if (bidx() == 0 && tidx() < 64) ((unsigned*)(fresh_params()->ws + OFF_CHK))[tidx()] = 0u;
#endif
#if NAN_POISON
  {
    KP kp = fresh_params();
    u32x4* w4 = (u32x4*)kp->ws; u32x4* o4 = (u32x4*)kp->out;
    const u32x4 pz = {0x7FC07FC0u, 0x7FC07FC0u, 0x7FC07FC0u, 0x7FC07FC0u};
    const size_t gt = (size_t)bidx() * NT + tidx(), gn = (size_t)gridDim.x * NT;
    for (size_t i = gt; i < WS_TOTAL / 16; i += gn) w4[i] = pz;
    for (size_t i = gt; i < (size_t)NLAT * 1024 / 4; i += gn) o4[i] = pz;
  }
  GS();
#endif
  phase0(fresh_params(), smem); GS_CG();
  if (REP_PHASE == 20) { phase0(fresh_params(), smem); GS(); }
#if DEBUG_CHECKS
  chk_mod(fresh_params()); GS();
#endif
#define RUN(n, call) do { for (int rep_ = 0; rep_ < ((REP_PHASE == (n)) ? 2 : 1); ++rep_) { call; GS(); } } while (0)
#pragma unroll 1
  for (int layer = 0; layer < 2; ++layer) {
    RUN(1, phase1(fresh_params(), layer));
    CHK(chk_norm(fresh_params(), layer, 1, (layer == 0) ? fresh_params()->in[I_X] : fresh_params()->out,
                 (layer == 0) ? fresh_params()->in[I_CTX] : (const float*)(fresh_params()->ws + OFF_XC), fresh_params()->in[I_N1G] + layer * 1024, 0, 1024, MTOT));
    RUN(2, phase2(fresh_params(), layer, smem));
    CHK(chk_proj(fresh_params(), layer));
    if (ONLY34 == 0 || ONLY34 == 4) phase4(fresh_params(), layer, smem);
    if (ONLY34 == 0 || ONLY34 == 3) phase3(fresh_params(), layer, smem);
    GS();
    CHK(chk_mla(fresh_params(), layer));

    if (REP_PHASE == 5) { phase5(fresh_params(), layer, smem, REP_SUB); GS(); }
    phase5(fresh_params(), layer, smem); GS();
    CHK(chk_attn(fresh_params(), layer));
    CHK(chk_s5(fresh_params(), layer, smem));
    RUN(6, phase6(fresh_params(), layer, smem));
    CHK(chk_glu(fresh_params(), layer));
    CHK(chk_gn(fresh_params()));
    if (REP_PHASE == 8 && layer == 0) { phase8(fresh_params(), layer, smem); GS(); }
    phase8(fresh_params(), layer, smem); GS();
    CHK(chk_out(fresh_params(), layer));
    RUN(9, phase9(fresh_params(), layer));
    CHK(chk_norm(fresh_params(), layer, 14, fresh_params()->out, (const float*)(fresh_params()->ws + OFF_XC), fresh_params()->in[I_N2G] + layer * 1024, 3072, 4096, NLAT));
    RUN(10, phase10(fresh_params(), layer, smem));
    CHK(chk_q(fresh_params(), layer));
    RUN(11, phase11(fresh_params(), layer, smem));
    CHK(chk_topk(fresh_params(), layer, smem));
    CHK(chk_peer_a(fresh_params(), layer));
    RUN(12, phase12a(fresh_params(), layer));
    RUN(13, phase12b(fresh_params(), layer));
    RUN(14, phase12c(fresh_params(), layer, smem));
    if (layer == 1) phase13(fresh_params());
    CHK(chk_peer_b(fresh_params(), layer));
  }
#if DEBUG_CHECKS
  chk_final(fresh_params());
#endif
}

extern "C" void kernel_launch(void* const* d_in, const int* in_sizes, int n_in, void* d_out, int out_size, void* d_ws, size_t ws_size,
                              hipStream_t stream) {
  static int grid_blocks = 0;
  if (!grid_blocks) {
    int dev = 0, cus = 0, per_cu = 0;
    (void)hipGetDevice(&dev);
    (void)hipDeviceGetAttribute(&cus, hipDeviceAttributeMultiprocessorCount, dev);
    (void)hipOccupancyMaxActiveBlocksPerMultiprocessor(&per_cu, mega_kernel, NT, 0);
    if (per_cu > 2) per_cu = 2;
    if (per_cu < 1) per_cu = 1;
    grid_blocks = cus * per_cu;
    if (ws_size < WS_TOTAL) fprintf(stderr, "kernel_launch: workspace too small: %zu < %zu\n", ws_size, (size_t)WS_TOTAL);
  }
  if (ws_size < WS_TOTAL + (DEBUG_CHECKS ? (1 << 20) : 0) || n_in != 31) return;
  Params p{};
  for (int i = 0; i < 31; ++i) p.in[i] = (const float*)d_in[i];
  p.out = (float*)d_out;
  p.ws = (unsigned char*)d_ws;
  (void)hipMemsetAsync((unsigned char*)d_ws + OFF_BAR, 0, BAR_BYTES, stream);
  void* args[] = {&p};
  hipError_t e = hipLaunchCooperativeKernel((void*)mega_kernel, dim3(grid_blocks), dim3(NT), args, 0, stream);
  if (e != hipSuccess) fprintf(stderr, "cooperative launch failed: %s (grid %d)\n", hipGetErrorString(e), grid_blocks);
}
```
